# Optimizing an MI355X kernel written in HIP

```python
import jax, jax.numpy as jnp
from jax import lax
import numpy as np

D_MODEL = 2048
BATCH = 2
SEQ = 16384
DEPTH = 1

HEAD_DIM = 128
A_Q_HEADS = 8
A_KV_HEADS = 2
B_HEADS = 8
DIL_WINDOWS = (128, 512, 2048)
DIL_RATES = (1, 4, 16)
N_DIL = 3
MEM_TOKENS = 256
MEM_HEADS = 4
D_FF = 5632
NUM_BUCKETS = 32
MAX_DISTANCE = 1024
GRID_W = 64
ROPE_THETA = 10000.0
QBLOCK = 128
EPS = 1e-6
NEG = -1e30

A_Q_W = A_Q_HEADS * HEAD_DIM
A_KV_W = A_KV_HEADS * HEAD_DIM
B_W = B_HEADS * HEAD_DIM
IN_W = A_Q_W + 2 * A_KV_W + 3 * N_DIL * B_W
MIX_W = A_Q_W + B_W
MEM_W = MEM_HEADS * HEAD_DIM

kernel_name = "hybrid_gqa_axial_dilated_memory_macaron"


def rms_norm(x, g):
    xf = x.astype(jnp.float32)
    y = xf * lax.rsqrt(jnp.mean(xf * xf, axis=-1, keepdims=True) + EPS)
    return (y * g.astype(jnp.float32)).astype(x.dtype)


def swiglu(h, w_gate, w_up, w_down):
    return (jax.nn.silu(h @ w_gate) * (h @ w_up)) @ w_down


def axial_rope_tables(seq_len):
    rows = seq_len // GRID_W
    row = jnp.repeat(jnp.arange(rows), GRID_W).astype(jnp.float32)
    col = jnp.tile(jnp.arange(GRID_W), rows).astype(jnp.float32)
    nf = HEAD_DIM // 4
    inv_freq = ROPE_THETA ** (-jnp.arange(nf, dtype=jnp.float32) / nf)
    ang = jnp.stack([row[:, None] * inv_freq, col[:, None] * inv_freq], axis=1)
    return jnp.cos(ang), jnp.sin(ang)


def apply_axial_rope(x, cos, sin):
    nf = HEAD_DIM // 4
    xs = x.astype(jnp.float32).reshape(*x.shape[:-1], 2, 2, nf)
    x1, x2 = xs[..., 0, :], xs[..., 1, :]
    c, s = cos[None, :, None], sin[None, :, None]
    out = jnp.stack([x1 * c - x2 * s, x2 * c + x1 * s], axis=-2)
    return out.reshape(x.shape).astype(x.dtype)


def t5_buckets(rel):
    nb = NUM_BUCKETS // 2
    max_exact = nb // 2
    ret = (rel > 0).astype(np.int32) * nb
    n = np.abs(rel)
    large = max_exact + (np.log(np.maximum(n, 1) / max_exact)
                         / np.log(MAX_DISTANCE / max_exact) * (nb - max_exact)).astype(np.int32)
    large = np.minimum(large, nb - 1)
    return (ret + np.where(n < max_exact, n, large)).astype(np.int32)


def gqa_axial_attention(q, k, v, cos, sin, g_q, g_k):
    bsz, seq_len = q.shape[:2]
    q = apply_axial_rope(rms_norm(q, g_q), cos, sin)
    k = apply_axial_rope(rms_norm(k, g_k), cos, sin)
    grp = A_Q_HEADS // A_KV_HEADS
    nblk = seq_len // QBLOCK
    qb = jnp.moveaxis(q.reshape(bsz, nblk, QBLOCK, A_KV_HEADS, grp, HEAD_DIM), 1, 0)
    scale = HEAD_DIM ** -0.5

    def block(qblk):
        s = jnp.einsum('bqkgd,bskd->bkgqs', qblk, k).astype(jnp.float32) * scale
        p = jax.nn.softmax(s, axis=-1).astype(v.dtype)
        return jnp.einsum('bkgqs,bskd->bqkgd', p, v)

    o = lax.map(block, qb)
    return jnp.moveaxis(o, 0, 1).reshape(bsz, seq_len, A_Q_W)


def dilated_group_attention(q, k, v, bias, dilation, side):
    bsz, seq_len, nh, dh = q.shape
    offsets = dilation * jnp.arange(-side, side + 1)
    nblk = seq_len // QBLOCK
    qb = jnp.moveaxis(q.reshape(bsz, nblk, QBLOCK, nh, dh), 1, 0)
    starts = jnp.arange(nblk) * QBLOCK
    scale = dh ** -0.5

    def block(args):
        qblk, start = args
        idx = start + jnp.arange(QBLOCK)[:, None] + offsets[None, :]
        valid = (idx >= 0) & (idx < seq_len)
        idx = jnp.clip(idx, 0, seq_len - 1)
        kg = k[:, idx]
        vg = v[:, idx]
        s = jnp.einsum('bqhd,bqwhd->bhqw', qblk, kg).astype(jnp.float32) * scale
        s = jnp.where(valid[None, None], s + bias[None, :, None, :], NEG)
        m = jnp.max(s, axis=-1, keepdims=True)
        p = jnp.exp(s - m)
        l = jnp.sum(p, axis=-1)
        o = jnp.einsum('bhqw,bqwhd->bqhd', p.astype(vg.dtype), vg).astype(jnp.float32)
        o = o / jnp.transpose(l, (0, 2, 1))[..., None]
        lse = jnp.transpose(m[..., 0] + jnp.log(l), (0, 2, 1))
        return o, lse

    o, lse = lax.map(block, (qb, starts))
    o = jnp.moveaxis(o, 0, 1).reshape(bsz, seq_len, nh, dh)
    lse = jnp.moveaxis(lse, 0, 1).reshape(bsz, seq_len, nh)
    return o, lse


def dilated_mixture(q, k, v, rel_bias):
    bsz, seq_len = q.shape[:2]
    outs, lses = [], []
    for g in range(N_DIL):
        side = DIL_WINDOWS[g] // (2 * DIL_RATES[g])
        rel = DIL_RATES[g] * np.arange(-side, side + 1)
        buckets = jnp.asarray(t5_buckets(rel))
        bias = rel_bias[:, g * B_HEADS:(g + 1) * B_HEADS].astype(jnp.float32)[buckets].T
        o, lse = dilated_group_attention(q[:, :, g], k[:, :, g], v[:, :, g], bias,
                                         DIL_RATES[g], side)
        outs.append(o)
        lses.append(lse)
    w = jax.nn.softmax(jnp.stack(lses, 0), axis=0)
    o = jnp.sum(w[..., None] * jnp.stack(outs, 0), axis=0)
    return o.reshape(bsz, seq_len, B_W).astype(q.dtype)


def memory_cross_attention(h, hm, w_q, w_kv, w_o):
    bsz, seq_len = h.shape[:2]
    q = (h @ w_q).reshape(bsz, seq_len, MEM_HEADS, HEAD_DIM)
    kv = hm @ w_kv
    k = kv[..., :MEM_W].reshape(bsz, -1, MEM_HEADS, HEAD_DIM)
    v = kv[..., MEM_W:].reshape(bsz, -1, MEM_HEADS, HEAD_DIM)
    s = jnp.einsum('bshd,bmhd->bhsm', q, k).astype(jnp.float32) * HEAD_DIM ** -0.5
    p = jax.nn.softmax(s, axis=-1).astype(v.dtype)
    o = jnp.einsum('bhsm,bmhd->bshd', p, v).reshape(bsz, seq_len, MEM_W)
    return o @ w_o


def setup_inputs(seed: int = 0) -> dict:
    key = jax.random.key(seed)
    ks = jax.random.split(key, 24)
    f32 = jnp.float32

    def dense(k, shape, fan_in):
        return jax.random.normal(k, shape, f32) * (fan_in ** -0.5)

    def gain(k, shape):
        return 1.0 + 0.05 * jax.random.normal(k, shape, f32)

    L = DEPTH
    return {
        "x": jax.random.normal(ks[0], (BATCH, SEQ, D_MODEL), f32),
        "mem": jax.random.normal(ks[1], (BATCH, MEM_TOKENS, D_MODEL), f32),
        "ffn1_norm": gain(ks[2], (L, D_MODEL)),
        "ffn1_w_gate": dense(ks[3], (L, D_MODEL, D_FF), D_MODEL),
        "ffn1_w_up": dense(ks[4], (L, D_MODEL, D_FF), D_MODEL),
        "ffn1_w_down": dense(ks[5], (L, D_FF, D_MODEL), D_FF),
        "mix_norm": gain(ks[6], (L, D_MODEL)),
        "w_in": dense(ks[7], (L, D_MODEL, IN_W), D_MODEL),
        "q_norm_a": gain(ks[8], (L, HEAD_DIM)),
        "k_norm_a": gain(ks[9], (L, HEAD_DIM)),
        "rel_bias": 0.1 * jax.random.normal(ks[10], (NUM_BUCKETS, N_DIL * B_HEADS), f32),
        "w_out": dense(ks[11], (L, MIX_W, D_MODEL), MIX_W),
        "mem_x_norm": gain(ks[12], (L, D_MODEL)),
        "mem_m_norm": gain(ks[13], (L, D_MODEL)),
        "w_q_mem": dense(ks[14], (L, D_MODEL, MEM_W), D_MODEL),
        "w_kv_mem": dense(ks[15], (L, D_MODEL, 2 * MEM_W), D_MODEL),
        "w_o_mem": dense(ks[16], (L, MEM_W, D_MODEL), MEM_W),
        "ffn2_norm": gain(ks[17], (L, D_MODEL)),
        "ffn2_w_gate": dense(ks[18], (L, D_MODEL, D_FF), D_MODEL),
        "ffn2_w_up": dense(ks[19], (L, D_MODEL, D_FF), D_MODEL),
        "ffn2_w_down": dense(ks[20], (L, D_FF, D_MODEL), D_FF),
        "final_norm": gain(ks[21], (D_MODEL,)),
    }


def reference(x, mem, ffn1_norm, ffn1_w_gate, ffn1_w_up, ffn1_w_down, mix_norm, w_in,
              q_norm_a, k_norm_a, rel_bias, w_out, mem_x_norm, mem_m_norm, w_q_mem,
              w_kv_mem, w_o_mem, ffn2_norm, ffn2_w_gate, ffn2_w_up, ffn2_w_down, final_norm):
    bsz, seq_len, _ = x.shape
    cos, sin = axial_rope_tables(seq_len)
    o_aq = A_Q_W
    o_ak = o_aq + A_KV_W
    o_av = o_ak + A_KV_W
    o_bq = o_av + N_DIL * B_W
    o_bk = o_bq + N_DIL * B_W
    for l in range(DEPTH):
        x = x + 0.5 * swiglu(rms_norm(x, ffn1_norm[l]), ffn1_w_gate[l], ffn1_w_up[l], ffn1_w_down[l])

        h = rms_norm(x, mix_norm[l])
        proj = h @ w_in[l]
        qa = proj[..., :o_aq].reshape(bsz, seq_len, A_Q_HEADS, HEAD_DIM)
        ka = proj[..., o_aq:o_ak].reshape(bsz, seq_len, A_KV_HEADS, HEAD_DIM)
        va = proj[..., o_ak:o_av].reshape(bsz, seq_len, A_KV_HEADS, HEAD_DIM)
        qb = proj[..., o_av:o_bq].reshape(bsz, seq_len, N_DIL, B_HEADS, HEAD_DIM)
        kb = proj[..., o_bq:o_bk].reshape(bsz, seq_len, N_DIL, B_HEADS, HEAD_DIM)
        vb = proj[..., o_bk:].reshape(bsz, seq_len, N_DIL, B_HEADS, HEAD_DIM)
        out_a = gqa_axial_attention(qa, ka, va, cos, sin, q_norm_a[l], k_norm_a[l])
        out_b = dilated_mixture(qb, kb, vb, rel_bias)
        x = x + jnp.concatenate([out_a, out_b], axis=-1) @ w_out[l]

        x = x + memory_cross_attention(rms_norm(x, mem_x_norm[l]), rms_norm(mem, mem_m_norm[l]),
                                       w_q_mem[l], w_kv_mem[l], w_o_mem[l])

        x = x + 0.5 * swiglu(rms_norm(x, ffn2_norm[l]), ffn2_w_gate[l], ffn2_w_up[l], ffn2_w_down[l])
    return rms_norm(x, final_norm)
```

```cpp
#include <hip/hip_runtime.h>
#include <hip/hip_bf16.h>
#include <hip/hip_cooperative_groups.h>
#include <cstdio>
#include <cstdint>
#include <cmath>
namespace cg = cooperative_groups;

#ifndef ATT_SD0
#define ATT_SD0 2
#endif
#ifndef MK_N_LAUNCHES
#define MK_N_LAUNCHES 1
#endif

namespace pg8 {
#define PG8_LAS __attribute__((address_space(3)))
typedef unsigned short bf16_t;
typedef short bf16x8 __attribute__((ext_vector_type(8)));
typedef float f32x4 __attribute__((ext_vector_type(4)));
typedef unsigned u32x4 __attribute__((ext_vector_type(4)));
constexpr int BM = 256, BK = 64, HALF = 128, HTB = HALF * BK * 2, STAGE_BYTES = 8 * HTB, NXCD = 8, WGM = 8;

__host__ __device__ __forceinline__ int lds_byte(int r, int c) { const int st = (r >> 4) * 2 + (c >> 5), rr = r & 15, cc = c & 31, ob = rr * 64 + cc * 2; return st * 1024 + (ob ^ (((ob >> 9) & 1) << 5)); }
__host__ __device__ __forceinline__ void stage_rc(int b, int& R, int& C) { const int st = b / 1024, sb = b % 1024, swz = sb ^ (((sb >> 9) & 1) << 5); R = (st >> 1) * 16 + swz / 64; C = (st & 1) * 32 + (swz % 64) / 2; }
__host__ __device__ __forceinline__ int perm32(int rho) { const int n = rho >> 4, i = rho & 15; return 8 * (i >> 2) + 4 * n + (i & 3); }

struct Unit { int pm, pn; };
struct Gemm { const bf16_t* A; const bf16_t* Bt; int M, N, K; };

struct StaticOrder {
    int nM, nN, nwg, G, c, wgm;
    __host__ __device__ void init(int M, int N, int G_, int c_, int wgm_ = WGM) { nM = M / BM; nN = N / BM; nwg = nM * nN; G = G_; c = c_; wgm = wgm_; }
    __host__ __device__ bool next(int i, Unit& u) const {
        const long L = (long)i * G + c; if (L >= nwg) return false;
        int wgid = (int)L; { const int q = nwg / NXCD, r = nwg % NXCD, xcd = wgid % NXCD, off = wgid / NXCD; wgid = (xcd < r ? xcd * (q + 1) : r * (q + 1) + (xcd - r) * q) + off; }
        const int nig = wgm * nN, gid = wgid / nig, fm = gid * wgm, gsz = (nM - fm) < wgm ? (nM - fm) : wgm;
        u.pm = fm + ((wgid % nig) % gsz); u.pn = (wgid % nig) / gsz; return true;
    }
    __device__ __forceinline__ void a_ready(const Unit&) const {}
    __device__ __forceinline__ void done(const Unit&) const {}
};

__device__ __forceinline__ unsigned cvt_pk_bf16(float lo, float hi) { unsigned r; asm volatile("v_cvt_pk_bf16_f32 %0, %1, %2" : "=v"(r) : "v"(lo), "v"(hi)); return r; }

template <bool NORM> struct EpiBf16 {
    static constexpr bool PERM = true, AFTER_DRAIN = false;
    bf16_t* O; int ldc; const float* ss;
    __device__ __forceinline__ void operator()(const f32x4 (&acc)[2][2][4][2], const Unit& u, int wr, int wc, int fr, int fq) const {
        const int row0 = u.pm * BM + wr * 64 + fr; const int col0 = u.pn * BM + wc * 32 + 8 * fq;
#pragma unroll
        for (int ai = 0; ai < 2; ++ai)
#pragma unroll
            for (int m = 0; m < 4; ++m) { const int row = row0 + ai * HALF + m * 16; bf16_t* rowp = O + (size_t)row * ldc + col0;
                float rs = 1.0f; if constexpr (NORM) rs = 1.0f / sqrtf(ss[row] * (1.0f / 2048.0f) + 1e-6f);
#pragma unroll
                for (int bj = 0; bj < 2; ++bj) { const f32x4 v0 = acc[ai][bj][m][0] * rs, v1 = acc[ai][bj][m][1] * rs;
                    u32x4 w; w.x = cvt_pk_bf16(v0[0], v0[1]); w.y = cvt_pk_bf16(v0[2], v0[3]); w.z = cvt_pk_bf16(v1[0], v1[1]); w.w = cvt_pk_bf16(v1[2], v1[3]);
                    *(u32x4*)(rowp + bj * HALF) = w; } }
    }
};
template <bool NORM> struct EpiSwiGLU {
    static constexpr bool PERM = true, AFTER_DRAIN = false;
    bf16_t* O; int ldc; const float* ss;
    __device__ __forceinline__ float act(float g, float u) const { const float e = __builtin_amdgcn_exp2f(-g * 1.4426950408889634f); return g * u * __builtin_amdgcn_rcpf(1.0f + e); }
    __device__ __forceinline__ void operator()(const f32x4 (&acc)[2][2][4][2], const Unit& u, int wr, int wc, int fr, int fq) const {
        const int row0 = u.pm * BM + wr * 64 + fr; const int col0 = u.pn * HALF + wc * 32 + 8 * fq;
#pragma unroll
        for (int ai = 0; ai < 2; ++ai)
#pragma unroll
            for (int m = 0; m < 4; ++m) { const int row = row0 + ai * HALF + m * 16; bf16_t* rowp = O + (size_t)row * ldc + col0;
                float rs = 1.0f; if constexpr (NORM) rs = 1.0f / sqrtf(ss[row] * (1.0f / 2048.0f) + 1e-6f);
                const f32x4 g0 = acc[ai][0][m][0] * rs, g1 = acc[ai][0][m][1] * rs, u0 = acc[ai][1][m][0] * rs, u1 = acc[ai][1][m][1] * rs;
                u32x4 w; w.x = cvt_pk_bf16(act(g0[0], u0[0]), act(g0[1], u0[1])); w.y = cvt_pk_bf16(act(g0[2], u0[2]), act(g0[3], u0[3]));
                w.z = cvt_pk_bf16(act(g1[0], u1[0]), act(g1[1], u1[1])); w.w = cvt_pk_bf16(act(g1[2], u1[2]), act(g1[3], u1[3]));
                *(u32x4*)rowp = w; }
    }
};
template <bool BASE_BF16, bool WRITE_F32, bool WRITE_XB> struct EpiRes {
    static constexpr bool PERM = true, AFTER_DRAIN = false;
    const float* base; const bf16_t* baseb; float* out; bf16_t* xb; float* ss; int ldc; float alpha;
    __device__ __forceinline__ void operator()(const f32x4 (&acc)[2][2][4][2], const Unit& u, int wr, int wc, int fr, int fq) const {
        const int row0 = u.pm * BM + wr * 64 + fr; const int col0 = u.pn * BM + wc * 32 + 8 * fq;
#pragma unroll
        for (int ai = 0; ai < 2; ++ai)
#pragma unroll
            for (int m = 0; m < 4; ++m) { const int row = row0 + ai * HALF + m * 16; const size_t off = (size_t)row * ldc + col0; float part = 0.f;
#pragma unroll
                for (int bj = 0; bj < 2; ++bj) { const size_t idx = off + bj * HALF;
                    f32x4 b0, b1;
                    if constexpr (BASE_BF16) { const u32x4 r = *(const u32x4*)(baseb + idx);
                        b0 = (f32x4){__builtin_bit_cast(float, r.x << 16), __builtin_bit_cast(float, r.x & 0xffff0000u), __builtin_bit_cast(float, r.y << 16), __builtin_bit_cast(float, r.y & 0xffff0000u)};
                        b1 = (f32x4){__builtin_bit_cast(float, r.z << 16), __builtin_bit_cast(float, r.z & 0xffff0000u), __builtin_bit_cast(float, r.w << 16), __builtin_bit_cast(float, r.w & 0xffff0000u)}; }
                    else { b0 = *(const f32x4*)(base + idx); b1 = *(const f32x4*)(base + idx + 4); }
                    const f32x4 o0 = b0 + acc[ai][bj][m][0] * alpha, o1 = b1 + acc[ai][bj][m][1] * alpha;
                    if constexpr (WRITE_F32) { *(f32x4*)(out + idx) = o0; *(f32x4*)(out + idx + 4) = o1; }
                    if constexpr (WRITE_XB) {
                        part += (o0[0] * o0[0] + o0[1] * o0[1]) + (o0[2] * o0[2] + o0[3] * o0[3]) + (o1[0] * o1[0] + o1[1] * o1[1]) + (o1[2] * o1[2] + o1[3] * o1[3]);
                        u32x4 w; w.x = cvt_pk_bf16(o0[0], o0[1]); w.y = cvt_pk_bf16(o0[2], o0[3]); w.z = cvt_pk_bf16(o1[0], o1[1]); w.w = cvt_pk_bf16(o1[2], o1[3]);
                        *(u32x4*)(xb + idx) = w; } }
                if constexpr (WRITE_XB) { part += __shfl_xor(part, 16); part += __shfl_xor(part, 32);
                    if (fq == 0) atomicAdd(ss + row, part); } }
    }
};
struct EpiFinal {
    static constexpr bool PERM = true, AFTER_DRAIN = false;
    const bf16_t* baseb; float* out; float* ss; unsigned* cnt; const float* gain; int ldc; float alpha; unsigned ntn;
    __device__ __forceinline__ void tile(const f32x4 (&acc)[2][2][4][2], int ai, int m, int bj, size_t idx, f32x4& o0, f32x4& o1) const {
        const u32x4 r = *(const u32x4*)(baseb + idx);
        const f32x4 b0 = (f32x4){__builtin_bit_cast(float, r.x << 16), __builtin_bit_cast(float, r.x & 0xffff0000u), __builtin_bit_cast(float, r.y << 16), __builtin_bit_cast(float, r.y & 0xffff0000u)};
        const f32x4 b1 = (f32x4){__builtin_bit_cast(float, r.z << 16), __builtin_bit_cast(float, r.z & 0xffff0000u), __builtin_bit_cast(float, r.w << 16), __builtin_bit_cast(float, r.w & 0xffff0000u)};
        o0 = b0 + acc[ai][bj][m][0] * alpha; o1 = b1 + acc[ai][bj][m][1] * alpha;
    }
    __device__ __forceinline__ void operator()(const f32x4 (&acc)[2][2][4][2], const Unit& u, int wr, int wc, int fr, int fq) const {
        const int row0 = u.pm * BM + wr * 64 + fr; const int col0 = u.pn * BM + wc * 32 + 8 * fq;
#pragma unroll
        for (int ai = 0; ai < 2; ++ai)
#pragma unroll
            for (int m = 0; m < 4; ++m) { const int row = row0 + ai * HALF + m * 16; const size_t off = (size_t)row * ldc + col0; float part = 0.f;
#pragma unroll
                for (int bj = 0; bj < 2; ++bj) { f32x4 o0, o1; tile(acc, ai, m, bj, off + bj * HALF, o0, o1);
                    part += (o0[0] * o0[0] + o0[1] * o0[1]) + (o0[2] * o0[2] + o0[3] * o0[3]) + (o1[0] * o1[0] + o1[1] * o1[1]) + (o1[2] * o1[2] + o1[3] * o1[3]); }
                part += __shfl_xor(part, 16); part += __shfl_xor(part, 32);
                if (fq == 0) atomicAdd(ss + row, part); }
        asm volatile("s_waitcnt vmcnt(0)" ::: "memory");
        __builtin_amdgcn_s_barrier();
        if (threadIdx.x == 0) {
            unsigned* c = cnt + 64 * u.pm;
            __hip_atomic_fetch_add(c, 1u, __ATOMIC_RELAXED, __HIP_MEMORY_SCOPE_AGENT);
            unsigned sp = 0;
            while (__hip_atomic_load(c, __ATOMIC_RELAXED, __HIP_MEMORY_SCOPE_AGENT) < ntn) { __builtin_amdgcn_s_sleep(2); if (++sp > (1u << 22)) break; }
        }
        asm volatile("s_waitcnt vmcnt(0) lgkmcnt(0)" ::: "memory");
        __builtin_amdgcn_s_barrier(); asm volatile("" ::: "memory");
        f32x4 gv[2][2];
#pragma unroll
        for (int bj = 0; bj < 2; ++bj) { gv[bj][0] = *(const f32x4*)(gain + col0 + bj * HALF); gv[bj][1] = *(const f32x4*)(gain + col0 + bj * HALF + 4); }
#pragma unroll
        for (int ai = 0; ai < 2; ++ai)
#pragma unroll
            for (int m = 0; m < 4; ++m) { const int row = row0 + ai * HALF + m * 16; const size_t off = (size_t)row * ldc + col0;
                const float sv = __hip_atomic_load(ss + row, __ATOMIC_RELAXED, __HIP_MEMORY_SCOPE_AGENT);
                const float rs = 1.0f / sqrtf(sv * (1.0f / 2048.0f) + 1e-6f);
#pragma unroll
                for (int bj = 0; bj < 2; ++bj) { f32x4 o0, o1; const size_t idx = off + bj * HALF; tile(acc, ai, m, bj, idx, o0, o1);
                    *(f32x4*)(out + idx) = o0 * rs * gv[bj][0]; *(f32x4*)(out + idx + 4) = o1 * rs * gv[bj][1]; } }
    }
};
struct EpiResidX {
    static constexpr bool PERM = true, AFTER_DRAIN = false;
    const float* base; float* out; bf16_t* xb; float* ss; int ldc; float alpha;
    __device__ __forceinline__ void operator()(const f32x4 (&acc)[2][2][4][2], const Unit& u, int wr, int wc, int fr, int fq) const {
        const int row0 = u.pm * BM + wr * 64 + fr; const int col0 = u.pn * BM + wc * 32 + 8 * fq;
#pragma unroll
        for (int ai = 0; ai < 2; ++ai)
#pragma unroll
            for (int m = 0; m < 4; ++m) { const int row = row0 + ai * HALF + m * 16; const size_t off = (size_t)row * ldc + col0; float part = 0.f;
#pragma unroll
                for (int bj = 0; bj < 2; ++bj) { const size_t idx = off + bj * HALF;
                    const f32x4 b0 = *(const f32x4*)(base + idx), b1 = *(const f32x4*)(base + idx + 4);
                    const f32x4 o0 = b0 + acc[ai][bj][m][0] * alpha, o1 = b1 + acc[ai][bj][m][1] * alpha;
                    *(f32x4*)(out + idx) = o0; *(f32x4*)(out + idx + 4) = o1;
                    part += (o0[0] * o0[0] + o0[1] * o0[1]) + (o0[2] * o0[2] + o0[3] * o0[3]) + (o1[0] * o1[0] + o1[1] * o1[1]) + (o1[2] * o1[2] + o1[3] * o1[3]);
                    u32x4 w; w.x = cvt_pk_bf16(o0[0], o0[1]); w.y = cvt_pk_bf16(o0[2], o0[3]); w.z = cvt_pk_bf16(o1[0], o1[1]); w.w = cvt_pk_bf16(o1[2], o1[3]);
                    *(u32x4*)(xb + idx) = w; }
                part += __shfl_xor(part, 16); part += __shfl_xor(part, 32);
                if (fq == 0) atomicAdd(ss + row, part); }
    }
};
struct EpiResid {
    static constexpr bool PERM = false, AFTER_DRAIN = false;
    const float* base; float* out; int ldc; float alpha;
    __device__ __forceinline__ void operator()(const f32x4 (&acc)[2][2][4][2], const Unit& u, int wr, int wc, int fr, int fq) const {
        const int row0 = u.pm * BM + wr * 64 + fr; const int col0 = u.pn * BM + wc * 32 + 4 * fq;
#pragma unroll
        for (int ai = 0; ai < 2; ++ai)
#pragma unroll
            for (int m = 0; m < 4; ++m) { const size_t off = (size_t)(row0 + ai * HALF + m * 16) * ldc + col0;
#pragma unroll
                for (int bj = 0; bj < 2; ++bj)
#pragma unroll
                    for (int n = 0; n < 2; ++n) { const size_t idx = off + bj * HALF + n * 16; const f32x4 b = *(const f32x4*)(base + idx);
                        *(f32x4*)(out + idx) = b + acc[ai][bj][m][n] * alpha; } }
    }
};

template <class Epi, class Sched, bool ALIGN_EPI = false, bool SP2 = false>
__device__ __forceinline__ void gemm_phase(PG8_LAS unsigned char* lds, const Gemm g, const Sched& S, const Epi& E) {
    int tid = threadIdx.x; asm volatile("" : "+v"(tid));
    const int wid = __builtin_amdgcn_readfirstlane(tid >> 6), lane = tid & 63, wr = wid >> 2, wc = wid & 3, fr = lane & 15, fq = lane >> 4;
    const int K = g.K, nt = K / BK;
    unsigned voffA[2], voffB[2];
#pragma unroll
    for (int i = 0; i < 2; ++i) { int R, C; stage_rc(tid * 16 + i * 8192, R, C); const int Rb = Epi::PERM ? ((R & ~31) + perm32(R & 31)) : R;
        voffA[i] = (unsigned)(R * K + C) * 2u; voffB[i] = (unsigned)(Rb * K + C) * 2u; }
    const size_t kstep = (size_t)(BK * 2);
    const size_t hstep = (size_t)HALF * K * 2;
    const size_t tstep = 2 * hstep;
    const unsigned ldsw = (unsigned)wid * 1024u;
    const int aoff = lds_byte(wr * 64 + fr, fq * 8), boff = lds_byte(wc * 32 + fr, fq * 8);
#define PG8_SA(b, h) (((b) * 2 + (h)) * HTB)
#define PG8_SB(b, h) ((4 + (b) * 2 + (h)) * HTB)
#define PG8_STAGE(bufoff, gbase, voff) do { _Pragma("unroll") for (int _i = 0; _i < 2; ++_i) \
        __builtin_amdgcn_global_load_lds((const unsigned*)((const char*)(gbase) + (voff)[_i]), (PG8_LAS unsigned*)(lds + (bufoff) + ldsw + _i * 8192), 16, 0, 0); } while (0)
#define PG8_LDA(dst, b, h) do { _Pragma("unroll") for (int m = 0; m < 4; ++m) _Pragma("unroll") for (int k = 0; k < 2; ++k) dst[m][k] = *(const PG8_LAS bf16x8*)(lds + PG8_SA(b, h) + aoff + m * 2048 + k * 1024); } while (0)
#define PG8_LDB(dst, b, h) do { _Pragma("unroll") for (int n = 0; n < 2; ++n) _Pragma("unroll") for (int k = 0; k < 2; ++k) dst[n][k] = *(const PG8_LAS bf16x8*)(lds + PG8_SB(b, h) + boff + n * 2048 + k * 1024); } while (0)
#define PG8_MMA(ai, bj, At, Bt) do { __builtin_amdgcn_s_setprio(1); _Pragma("unroll") for (int m = 0; m < 4; ++m) _Pragma("unroll") for (int n = 0; n < 2; ++n) _Pragma("unroll") for (int k = 0; k < 2; ++k) \
        acc[ai][bj][m][n] = __builtin_amdgcn_mfma_f32_16x16x32_bf16(Bt[n][k], At[m][k], acc[ai][bj][m][n], 0, 0, 0); __builtin_amdgcn_s_setprio(0); } while (0)
#define PG8_WAIT_V(n) asm volatile("s_waitcnt vmcnt(" #n ")" ::: "memory")
#define PG8_WAIT_L(n) asm volatile("s_waitcnt lgkmcnt(" #n ")" ::: "memory")
#define PG8_BAR __builtin_amdgcn_s_barrier()
#define PG8_SCHED __builtin_amdgcn_sched_barrier(0)
    Unit cur, nxt; int ui = 0;
    if (!S.next(0, cur)) return;
    f32x4 acc[2][2][4][2];
#pragma unroll
    for (int a = 0; a < 2; ++a)
#pragma unroll
        for (int b = 0; b < 2; ++b)
#pragma unroll
            for (int m = 0; m < 4; ++m)
#pragma unroll
                for (int n = 0; n < 2; ++n) acc[a][b][m][n] = (f32x4){0.f, 0.f, 0.f, 0.f};
    bf16x8 At[4][2], B0[2][2], B1[2][2];
    const char* cA = (const char*)g.A + (size_t)cur.pm * tstep; const char* cB = (const char*)g.Bt + (size_t)cur.pn * tstep;
    S.a_ready(cur);
    if constexpr (SP2) {
        PG8_STAGE(PG8_SB(0, 0), cB, voffB); PG8_STAGE(PG8_SB(0, 1), cB + hstep, voffB); PG8_STAGE(PG8_SA(0, 0), cA, voffA); PG8_STAGE(PG8_SA(0, 1), cA + hstep, voffA);
        if (wr == 1) PG8_BAR;
        PG8_WAIT_V(2); PG8_BAR;
        PG8_STAGE(PG8_SB(1, 0), cB + kstep, voffB); PG8_STAGE(PG8_SA(1, 0), cA + kstep, voffA); PG8_STAGE(PG8_SB(1, 1), cB + hstep + kstep, voffB);
        PG8_WAIT_V(6); PG8_BAR;
    } else {
        PG8_STAGE(PG8_SB(0, 0), cB, voffB); PG8_STAGE(PG8_SA(0, 0), cA, voffA); PG8_STAGE(PG8_SB(0, 1), cB + hstep, voffB); PG8_STAGE(PG8_SA(0, 1), cA + hstep, voffA);
        if (wr == 1) PG8_BAR;
        PG8_WAIT_V(4); PG8_BAR;
        PG8_STAGE(PG8_SB(1, 0), cB + kstep, voffB); PG8_STAGE(PG8_SA(1, 0), cA + kstep, voffA); PG8_STAGE(PG8_SB(1, 1), cB + hstep + kstep, voffB);
        PG8_WAIT_V(6); PG8_BAR;
    }
    for (;;) {
        const bool has_next = S.next(ui + 1, nxt);
        const char* nA = has_next ? (const char*)g.A + (size_t)nxt.pm * tstep : cA; const char* nB = has_next ? (const char*)g.Bt + (size_t)nxt.pn * tstep : cB;
        for (int t = 0; t < nt; t += 2) {
            const bool last = (t == nt - 2);
            const char* a1 = cA + (size_t)(t + 1) * kstep;
            const char* a2 = last ? nA : cA + (size_t)(t + 2) * kstep; const char* b2 = last ? nB : cB + (size_t)(t + 2) * kstep;
            const char* a3 = a2 + kstep; const char* b3 = b2 + kstep;
            if (last && has_next) S.a_ready(nxt);
            if constexpr (SP2) {
            PG8_LDB(B0, 0, 0); PG8_LDB(B1, 0, 1); PG8_SCHED; PG8_LDA(At, 0, 0); PG8_STAGE(PG8_SA(1, 1), a1 + hstep, voffA);
            PG8_WAIT_V(8); PG8_WAIT_L(0); PG8_BAR; PG8_MMA(0, 0, At, B0); PG8_MMA(0, 1, At, B1); PG8_BAR; PG8_SCHED;
            PG8_LDA(At, 0, 1); PG8_STAGE(PG8_SB(0, 0), b2, voffB); PG8_STAGE(PG8_SB(0, 1), b2 + hstep, voffB); PG8_STAGE(PG8_SA(0, 0), a2, voffA);
            PG8_WAIT_V(8); PG8_WAIT_L(0); PG8_BAR; PG8_MMA(1, 0, At, B0); PG8_MMA(1, 1, At, B1); PG8_BAR; PG8_SCHED;
            PG8_LDB(B0, 1, 0); PG8_LDB(B1, 1, 1); PG8_SCHED; PG8_LDA(At, 1, 0); PG8_STAGE(PG8_SA(0, 1), a2 + hstep, voffA);
            PG8_WAIT_V(8); PG8_WAIT_L(0); PG8_BAR; PG8_MMA(0, 0, At, B0); PG8_MMA(0, 1, At, B1); PG8_BAR; PG8_SCHED;
            PG8_LDA(At, 1, 1); PG8_STAGE(PG8_SB(1, 0), b3, voffB); PG8_STAGE(PG8_SB(1, 1), b3 + hstep, voffB); PG8_STAGE(PG8_SA(1, 0), a3, voffA);
            PG8_WAIT_V(8); PG8_WAIT_L(0); PG8_BAR; PG8_MMA(1, 0, At, B0); PG8_MMA(1, 1, At, B1); PG8_BAR; PG8_SCHED;
            } else {
            PG8_LDB(B0, 0, 0); PG8_SCHED; PG8_LDA(At, 0, 0); PG8_STAGE(PG8_SA(1, 1), a1 + hstep, voffA);
            PG8_WAIT_L(8); PG8_BAR; PG8_WAIT_L(0); PG8_MMA(0, 0, At, B0); PG8_BAR; PG8_SCHED;
            PG8_LDB(B1, 0, 1); PG8_STAGE(PG8_SB(0, 0), b2, voffB);
            PG8_BAR; PG8_WAIT_L(0); PG8_MMA(0, 1, At, B1); PG8_BAR;
            PG8_LDA(At, 0, 1); PG8_STAGE(PG8_SA(0, 0), a2, voffA);
            PG8_BAR; PG8_WAIT_L(0); PG8_MMA(1, 0, At, B0); PG8_BAR; PG8_SCHED;
            PG8_STAGE(PG8_SB(0, 1), b2 + hstep, voffB);
            PG8_WAIT_V(6); PG8_BAR; PG8_MMA(1, 1, At, B1); PG8_BAR;
            PG8_LDB(B0, 1, 0); PG8_SCHED; PG8_LDA(At, 1, 0); PG8_STAGE(PG8_SA(0, 1), a2 + hstep, voffA);
            PG8_WAIT_L(8); PG8_BAR; PG8_WAIT_L(0); PG8_MMA(0, 0, At, B0); PG8_BAR; PG8_SCHED;
            PG8_LDB(B1, 1, 1); PG8_STAGE(PG8_SB(1, 0), b3, voffB);
            PG8_BAR; PG8_WAIT_L(0); PG8_MMA(0, 1, At, B1); PG8_BAR;
            PG8_LDA(At, 1, 1); PG8_STAGE(PG8_SA(1, 0), a3, voffA);
            PG8_BAR; PG8_WAIT_L(0); PG8_MMA(1, 0, At, B0); PG8_BAR; PG8_SCHED;
            PG8_STAGE(PG8_SB(1, 1), b3 + hstep, voffB);
            PG8_WAIT_V(6); PG8_BAR; PG8_MMA(1, 1, At, B1); PG8_BAR;
            }
        }
        if constexpr (ALIGN_EPI) { if (wr == 0) PG8_BAR; }
        if constexpr (!Epi::AFTER_DRAIN) { E(acc, cur, wr, wc, fr, fq); S.done(cur); }
        if (!has_next) break;
#pragma unroll
        for (int a = 0; a < 2; ++a)
#pragma unroll
            for (int b = 0; b < 2; ++b)
#pragma unroll
                for (int m = 0; m < 4; ++m)
#pragma unroll
                    for (int n = 0; n < 2; ++n) acc[a][b][m][n] = (f32x4){0.f, 0.f, 0.f, 0.f};
        cur = nxt; cA = nA; cB = nB; ++ui;
        if constexpr (ALIGN_EPI) { if (wr == 1) PG8_BAR; }
    }
    PG8_WAIT_V(0);
    if constexpr (!ALIGN_EPI) { if (wr == 0) PG8_BAR; }
    PG8_BAR;
#undef PG8_SA
#undef PG8_SB
#undef PG8_STAGE
#undef PG8_LDA
#undef PG8_LDB
#undef PG8_MMA
#undef PG8_WAIT_V
#undef PG8_WAIT_L
#undef PG8_BAR
#undef PG8_SCHED
}
}

namespace att {
using bf16 = __hip_bfloat16;
constexpr int D = 128, NW = 8, QBLK = 32, KVBLK = 64;
constexpr float SCALE = 0.088388347648318440f;
constexpr float THR = 8.f;
constexpr size_t SHM_V = KVBLK * D * 2, SHM_K = KVBLK * D * 2, SHM_ATTN = 2 * SHM_V + 2 * SHM_K + NW * 64 * 4;
constexpr int TAB_N = 640, TAB_PAD = 320;
using bf16x8 = __attribute__((ext_vector_type(8))) short;
using s16x4  = __attribute__((ext_vector_type(4))) short;
using f32x16 = __attribute__((ext_vector_type(16))) float;
using u32x4  = __attribute__((ext_vector_type(4))) unsigned;
#define KSWZ(row, colB) ((row) * 256 + ((colB) ^ (((row) & 7) << 4)))
#define SBAR() __builtin_amdgcn_sched_barrier(0)
__device__ __forceinline__ int crow(int r, int hi) { return (r & 3) + 8 * (r >> 2) + 4 * hi; }
__device__ __forceinline__ unsigned cvtpk(float lo, float hi) { unsigned r; asm volatile("v_cvt_pk_bf16_f32 %0, %1, %2" : "=v"(r) : "v"(lo), "v"(hi)); return r; }

__device__ __forceinline__ void partialSM(f32x16& p0, f32x16& p1, float& m_reg, float& mn, float& alpha) {
  constexpr float C = SCALE * 1.4426950408889634f;
  float pmax = p0[0];
#pragma unroll
  for (int r = 1; r < 16; ++r) pmax = fmaxf(pmax, p0[r]);
#pragma unroll
  for (int r = 0; r < 16; ++r) pmax = fmaxf(pmax, p1[r]);
  { auto rr = __builtin_amdgcn_permlane32_swap(__float_as_uint(pmax), __float_as_uint(pmax), false, false);
    pmax = fmaxf(__uint_as_float(rr[0]), __uint_as_float(rr[1])); }
  if (__builtin_expect(__all(pmax - m_reg <= THR / SCALE), 1)) { mn = m_reg; alpha = 1.f; }
  else { mn = fmaxf(m_reg, pmax); alpha = __builtin_amdgcn_exp2f((m_reg - mn) * C); m_reg = mn; }
  float mnC = -mn * C;
#pragma unroll
  for (int r = 0; r < 16; ++r) p0[r] = fmaf(p0[r], C, mnC);
#pragma unroll
  for (int r = 0; r < 16; ++r) p1[r] = fmaf(p1[r], C, mnC);
#pragma unroll
  for (int r = 0; r < 16; ++r) p0[r] = __builtin_amdgcn_exp2f(p0[r]);
}
__device__ __forceinline__ void finishSM(f32x16& p0, f32x16& p1, float alpha, float& l_reg, bf16x8& pa0, bf16x8& pa1, bf16x8& pa2, bf16x8& pa3) {
#pragma unroll
  for (int r = 0; r < 16; ++r) p1[r] = __builtin_amdgcn_exp2f(p1[r]);
  float ps = 0;
#pragma unroll
  for (int r = 0; r < 16; ++r) ps += p0[r];
#pragma unroll
  for (int r = 0; r < 16; ++r) ps += p1[r];
  { auto rr = __builtin_amdgcn_permlane32_swap(__float_as_uint(ps), __float_as_uint(ps), false, false);
    ps = __uint_as_float(rr[0]) + __uint_as_float(rr[1]); }
  l_reg = l_reg * alpha + ps;
#define PK4(P, BASE, OUT) do { unsigned a0 = cvtpk(P[BASE + 0], P[BASE + 1]), a1 = cvtpk(P[BASE + 2], P[BASE + 3]);   \
    unsigned b0 = cvtpk(P[BASE + 4], P[BASE + 5]), b1 = cvtpk(P[BASE + 6], P[BASE + 7]);                              \
    auto r0 = __builtin_amdgcn_permlane32_swap(a0, b0, false, false); auto r1 = __builtin_amdgcn_permlane32_swap(a1, b1, false, false); \
    u32x4 w = {r0[0], r1[0], r0[1], r1[1]}; OUT = *reinterpret_cast<bf16x8*>(&w); } while (0)
  PK4(p0, 0, pa0); PK4(p0, 8, pa1); PK4(p1, 0, pa2); PK4(p1, 8, pa3);
#undef PK4
}
__device__ __forceinline__ void qkt(f32x16& p0, f32x16& p1, const bf16* Ks, const bf16x8* qr, int r32, int hi) {
  p0 = f32x16{}; p1 = f32x16{};
#pragma unroll
  for (int d0 = 0; d0 < 8; ++d0) { int cb = (d0 * 16 + hi * 8) * 2;
    bf16x8 b0 = *reinterpret_cast<const bf16x8*>((const char*)Ks + KSWZ(r32, cb));
    bf16x8 b1 = *reinterpret_cast<const bf16x8*>((const char*)Ks + KSWZ(32 + r32, cb));
    p0 = __builtin_amdgcn_mfma_f32_32x32x16_bf16(b0, qr[d0], p0, 0, 0, 0);
    p1 = __builtin_amdgcn_mfma_f32_32x32x16_bf16(b1, qr[d0], p1, 0, 0, 0); }
}
__device__ __forceinline__ int v_st(int k, int c) { const int kk = (k & ~0xC) | ((k & 4) << 1) | ((k & 8) >> 1); return ((kk >> 3) * 4 + (c >> 5)) * 512 + ((kk & 7) * 32 + (c & 31)) * 2; }
__device__ __forceinline__ int v_rd_base(int lane) { return ((lane & 3) << 3) | (((lane >> 2) & 3) << 6) | (((lane >> 4) & 1) << 5) | (((lane >> 5) & 1) << 8); }
constexpr int v_rd_off(int d0, int ks, int half) { return d0 * 512 + ks * 4096 + half * 2048; }
template <int OFF> __device__ __forceinline__ s16x4 tr_read(int vb) {
  s16x4 r; asm volatile("ds_read_b64_tr_b16 %0, %1 offset:%2" : "=&v"(r) : "v"(vb), "i"(OFF) : "memory"); return r;
}
template <int D0> __device__ __forceinline__ void pv_one(f32x16& od, int vb, bf16x8 pa0, bf16x8 pa1, bf16x8 pa2, bf16x8 pa3) {
  const s16x4 l0 = tr_read<v_rd_off(D0, 0, 0)>(vb), h0 = tr_read<v_rd_off(D0, 0, 1)>(vb), l1 = tr_read<v_rd_off(D0, 1, 0)>(vb), h1 = tr_read<v_rd_off(D0, 1, 1)>(vb);
  const s16x4 l2 = tr_read<v_rd_off(D0, 2, 0)>(vb), h2 = tr_read<v_rd_off(D0, 2, 1)>(vb), l3 = tr_read<v_rd_off(D0, 3, 0)>(vb), h3 = tr_read<v_rd_off(D0, 3, 1)>(vb);
  asm volatile("s_waitcnt lgkmcnt(0)" ::: "memory"); SBAR();
#define PK(L, H) (bf16x8){L[0], L[1], L[2], L[3], H[0], H[1], H[2], H[3]}
  od = __builtin_amdgcn_mfma_f32_32x32x16_bf16(pa0, PK(l0, h0), od, 0, 0, 0);
  od = __builtin_amdgcn_mfma_f32_32x32x16_bf16(pa1, PK(l1, h1), od, 0, 0, 0);
  od = __builtin_amdgcn_mfma_f32_32x32x16_bf16(pa2, PK(l2, h2), od, 0, 0, 0);
  od = __builtin_amdgcn_mfma_f32_32x32x16_bf16(pa3, PK(l3, h3), od, 0, 0, 0);
#undef PK
}
__device__ __forceinline__ void pv_d0(f32x16* o, int vb, bf16x8 pa0, bf16x8 pa1, bf16x8 pa2, bf16x8 pa3) {
  pv_one<0>(o[0], vb, pa0, pa1, pa2, pa3); pv_one<1>(o[1], vb, pa0, pa1, pa2, pa3); pv_one<2>(o[2], vb, pa0, pa1, pa2, pa3); pv_one<3>(o[3], vb, pa0, pa1, pa2, pa3);
}

template <int MODE, bool QPREP = false>
__device__ __forceinline__ void attn_unit(const bf16* __restrict__ Qb, long ldq, const bf16* __restrict__ Kh, const bf16* __restrict__ Vh, long ldk,
                                          bf16* Ob, long ldo, int NT, char* lds, int kpos0, int npos, const float* tab, float* lse_out, long lse_stride, const float* qgain = nullptr, int qs0 = 0) {
  int tid = threadIdx.x; asm volatile("" : "+v"(tid));
  const int wid = __builtin_amdgcn_readfirstlane(tid >> 6), lane = tid & 63, r32 = lane & 31, hi = lane >> 5;
  constexpr int KOFF = (MODE == 0) ? 0 : (int)(2 * SHM_V), VOFF = (MODE == 0) ? 65536 : 0, WSOFF = (MODE == 0) ? (131072 + 1024) : (int)(2 * SHM_V + 2 * SHM_K);
  bf16* V_lds = (bf16*)(lds + VOFF); bf16* K_lds = (bf16*)(lds + KOFF);
  float* ws = (float*)(lds + WSOFF) + wid * 64; float* li_l = ws; float* al_l = ws + 32;
  float m_reg = -1e30f, l_reg = 0; f32x16 o[4] = {}; bf16x8 qr[8];
  const bf16* Qw = Qb + (long)(wid * QBLK + r32) * ldq + hi * 8;
#pragma unroll
  for (int d0 = 0; d0 < 8; ++d0) qr[d0] = *reinterpret_cast<const bf16x8*>(Qw + d0 * 16);
  if constexpr (QPREP) {
    float x[8][8]; float ssq = 0.f;
#pragma unroll
    for (int d0 = 0; d0 < 8; ++d0)
#pragma unroll
      for (int j = 0; j < 8; ++j) { x[d0][j] = __builtin_bit_cast(float, (unsigned)(unsigned short)qr[d0][j] << 16); ssq += x[d0][j] * x[d0][j]; }
    { auto rr = __builtin_amdgcn_permlane32_swap(__float_as_uint(ssq), __float_as_uint(ssq), false, false); ssq = __uint_as_float(rr[0]) + __uint_as_float(rr[1]); }
    const float rstd = 1.0f / sqrtf(ssq * (1.0f / 128.0f) + 1e-6f);
    const int sq = qs0 + wid * QBLK + r32;
#pragma unroll
    for (int aa = 0; aa < 2; ++aa) { const float pos = (float)(aa == 0 ? (sq >> 6) : (sq & 63));
#pragma unroll
      for (int dd = 0; dd < 2; ++dd) { const int d0 = aa * 4 + dd;
#pragma unroll
        for (int j = 0; j < 8; ++j) { const int i = 16 * dd + 8 * hi + j; const int e1 = aa * 64 + i;
          const float rev = pos * exp2f(-(float)i * 0.41524101186092029f) * 0.15915494309189535f;
          const float sn = __builtin_amdgcn_sinf(rev), cs = __builtin_amdgcn_cosf(rev);
          const float y1 = x[d0][j] * rstd * qgain[e1], y2 = x[d0 + 2][j] * rstd * qgain[e1 + 32];
          x[d0][j] = y1 * cs - y2 * sn; x[d0 + 2][j] = y2 * cs + y1 * sn; } } }
#pragma unroll
    for (int d0 = 0; d0 < 8; ++d0) { u32x4 w = {cvtpk(x[d0][0], x[d0][1]), cvtpk(x[d0][2], x[d0][3]), cvtpk(x[d0][4], x[d0][5]), cvtpk(x[d0][6], x[d0][7])}; qr[d0] = *reinterpret_cast<bf16x8*>(&w); }
  }
  const int sr = tid >> 4, sc = (tid & 15) * 8, vst0 = v_st(sr, sc), vst1 = vst0 + 8192;
  const int vb0 = (int)(uintptr_t)V_lds + v_rd_base(lane);
  const int qrel = wid * QBLK + r32;
  constexpr int SD = (MODE == 0) ? ATT_SD0 : 2;
  struct { bf16x8 vs0, vs1, ks0, ks1; } sr_[SD];
  const unsigned soff0 = (unsigned)(sr * (int)ldk + sc) * 2u, soff1 = soff0 + (unsigned)(32 * (int)ldk) * 2u;
#define KPOS(j) ((MODE == 1) ? ((kpos0 + (j) * KVBLK >= 0 && kpos0 + (j) * KVBLK < npos) ? (kpos0 + (j) * KVBLK) : 0) : ((j) * KVBLK))
#define SLOAD(i, j) do { const size_t kb_ = (size_t)KPOS(j) * (size_t)ldk * 2; const char* Kt_ = (const char*)Kh + kb_; const char* Vt_ = (const char*)Vh + kb_; \
    sr_[i].vs0 = *reinterpret_cast<const bf16x8*>(Vt_ + soff0); sr_[i].vs1 = *reinterpret_cast<const bf16x8*>(Vt_ + soff1); \
    sr_[i].ks0 = *reinterpret_cast<const bf16x8*>(Kt_ + soff0); sr_[i].ks1 = *reinterpret_cast<const bf16x8*>(Kt_ + soff1); } while (0)
#define SWRITE(b, i) do { *(bf16x8*)((char*)V_lds + (b) * SHM_V + vst0) = sr_[i].vs0;          \
    *(bf16x8*)((char*)V_lds + (b) * SHM_V + vst1) = sr_[i].vs1; int kc = sc * 2;               \
    *(bf16x8*)((char*)K_lds + (b) * SHM_K + KSWZ(sr, kc)) = sr_[i].ks0;                       \
    *(bf16x8*)((char*)K_lds + (b) * SHM_K + KSWZ(32 + sr, kc)) = sr_[i].ks1; } while (0)
#define SWAIT() do { if constexpr (SD == 2) asm volatile("s_waitcnt vmcnt(4)" ::: "memory"); else asm volatile("s_waitcnt vmcnt(0)" ::: "memory"); } while (0)
#define RESC(a) do { if (__any((a) < 1.f)) { if (hi == 0) al_l[r32] = (a); asm volatile("s_waitcnt lgkmcnt(0)" ::: "memory"); \
    _Pragma("unroll") for (int d = 0; d < 4; ++d) _Pragma("unroll") for (int r = 0; r < 16; ++r) o[d][r] *= al_l[crow(r, hi)]; } } while (0)
#define BIASM(P0, P1, j) do { if constexpr (MODE == 1) { const int kp_ = kpos0 + (j) * KVBLK; \
    if (kp_ >= 0 && kp_ < npos) { const float* tb_ = tab + ((j) * KVBLK - 64 + 4 * hi - qrel + TAB_PAD); \
      _Pragma("unroll") for (int r = 0; r < 16; ++r) { P0[r] += tb_[(r & 3) + 8 * (r >> 2)]; P1[r] += tb_[32 + (r & 3) + 8 * (r >> 2)]; } } \
    else { _Pragma("unroll") for (int r = 0; r < 16; ++r) { P0[r] = -INFINITY; P1[r] = -INFINITY; } } } } while (0)
  if constexpr (MODE == 1) {
    f32x16 pA0, pA1; float mnA, alA; bf16x8 pa0, pa1, pa2, pa3;
    const int jlo = wid >> 1;
    SLOAD(0, 0); SLOAD(1, 1);
    for (int j = 0; j < NT; j += 2) {
      SWRITE(0, 0); __syncthreads();
      if (j + 2 < NT) SLOAD(0, j + 2);
      if (j >= jlo && j <= jlo + 2) {
        qkt(pA0, pA1, K_lds, qr, r32, hi); BIASM(pA0, pA1, j); partialSM(pA0, pA1, m_reg, mnA, alA);
        RESC(alA);
        finishSM(pA0, pA1, alA, l_reg, pa0, pa1, pa2, pa3); SBAR();
        pv_d0(o, vb0, pa0, pa1, pa2, pa3);
      }
      SWRITE(1, 1); __syncthreads();
      if (j + 3 < NT) SLOAD(1, j + 3);
      if (j + 1 >= jlo && j + 1 <= jlo + 2) {
        qkt(pA0, pA1, (bf16*)((char*)K_lds + SHM_K), qr, r32, hi); BIASM(pA0, pA1, j + 1); partialSM(pA0, pA1, m_reg, mnA, alA);
        RESC(alA);
        finishSM(pA0, pA1, alA, l_reg, pa0, pa1, pa2, pa3); SBAR();
        pv_d0(o, vb0 + (int)SHM_V, pa0, pa1, pa2, pa3);
      }
    }
  } else {
  f32x16 pA0, pA1, pB0, pB1; float mnA, mnB, alA, alB; bf16x8 pa0, pa1, pa2, pa3;
  bf16x8 pv0_, pv1_, pv2_, pv3_, pk0_, pk1_, pk2_, pk3_;
  const int NP = NT >> 1;
  const unsigned rstep = (unsigned)(32 * (int)ldk) * 2u;
#define PLOADK(pp) do { const size_t kb_ = (size_t)(pp) * 128 * (size_t)ldk * 2; const char* Kt_ = (const char*)Kh + kb_ + soff0; \
    pk0_ = *reinterpret_cast<const bf16x8*>(Kt_); pk1_ = *reinterpret_cast<const bf16x8*>(Kt_ + rstep); pk2_ = *reinterpret_cast<const bf16x8*>(Kt_ + 2 * rstep); pk3_ = *reinterpret_cast<const bf16x8*>(Kt_ + 3 * rstep); } while (0)
#define PLOADV(pp) do { const size_t kb_ = (size_t)(pp) * 128 * (size_t)ldk * 2; const char* Vt_ = (const char*)Vh + kb_ + soff0; \
    pv0_ = *reinterpret_cast<const bf16x8*>(Vt_); pv1_ = *reinterpret_cast<const bf16x8*>(Vt_ + rstep); pv2_ = *reinterpret_cast<const bf16x8*>(Vt_ + 2 * rstep); pv3_ = *reinterpret_cast<const bf16x8*>(Vt_ + 3 * rstep); } while (0)
#define PLOAD(pp) do { PLOADK(pp); PLOADV(pp); } while (0)
#define PWRITE(c) do { const int kc = sc * 2; char* vb_ = (char*)V_lds + (c) * 32768; char* kb2_ = (char*)K_lds + (c) * 32768; \
    *(bf16x8*)(vb_ + vst0) = pv0_; *(bf16x8*)(vb_ + vst1) = pv1_; *(bf16x8*)(vb_ + 16384 + vst0) = pv2_; *(bf16x8*)(vb_ + 16384 + vst1) = pv3_; \
    *(bf16x8*)(kb2_ + KSWZ(sr, kc)) = pk0_; *(bf16x8*)(kb2_ + KSWZ(32 + sr, kc)) = pk1_; *(bf16x8*)(kb2_ + 16384 + KSWZ(sr, kc)) = pk2_; *(bf16x8*)(kb2_ + 16384 + KSWZ(32 + sr, kc)) = pk3_; } while (0)
#define KSUB(c, sb) ((bf16*)((char*)K_lds + (c) * 32768 + (sb) * 16384))
#define VSUB(c, sb) (vb0 + (c) * 32768 + (sb) * 16384)
  PLOAD(0); asm volatile("s_waitcnt vmcnt(0)" ::: "memory"); PWRITE(0); __syncthreads();
  qkt(pA0, pA1, KSUB(0, 0), qr, r32, hi); partialSM(pA0, pA1, m_reg, mnA, alA);
#define PAIR_FULL(c, oc, NEXTP) do { \
    SBAR(); PLOADK(NEXTP); qkt(pB0, pB1, KSUB(c, 1), qr, r32, hi); \
    finishSM(pA0, pA1, alA, l_reg, pa0, pa1, pa2, pa3); SBAR(); \
    PLOADV(NEXTP); \
    pv_d0(o, VSUB(c, 0), pa0, pa1, pa2, pa3); partialSM(pB0, pB1, m_reg, mnB, alB); \
    RESC(alB); \
    PWRITE(oc); \
    __syncthreads(); \
    SBAR(); qkt(pA0, pA1, KSUB(oc, 0), qr, r32, hi); \
    finishSM(pB0, pB1, alB, l_reg, pa0, pa1, pa2, pa3); SBAR(); \
    pv_d0(o, VSUB(c, 1), pa0, pa1, pa2, pa3); partialSM(pA0, pA1, m_reg, mnA, alA); \
    RESC(alA); \
    __syncthreads(); } while (0)
  for (int p = 0; p + 2 < NP; p += 2) {
    PAIR_FULL(0, 1, p + 1);
    PAIR_FULL(1, 0, p + 2);
  }
  PAIR_FULL(0, 1, NP - 1);
  { SBAR(); qkt(pB0, pB1, KSUB(1, 1), qr, r32, hi);
    finishSM(pA0, pA1, alA, l_reg, pa0, pa1, pa2, pa3); SBAR();
    pv_d0(o, VSUB(1, 0), pa0, pa1, pa2, pa3); partialSM(pB0, pB1, m_reg, mnB, alB);
    RESC(alB);
    finishSM(pB0, pB1, alB, l_reg, pa0, pa1, pa2, pa3); SBAR();
    pv_d0(o, VSUB(1, 1), pa0, pa1, pa2, pa3); }
#undef PAIR_FULL
#undef PLOAD
#undef PLOADK
#undef PLOADV
#undef PWRITE
#undef KSUB
#undef VSUB
  }
  if (hi == 0) li_l[r32] = l_reg; asm volatile("s_waitcnt lgkmcnt(0)" ::: "memory");
  if constexpr (MODE == 1) { if (hi == 0) lse_out[(long)(wid * QBLK + r32) * lse_stride] = m_reg * SCALE + __logf(l_reg); }
  float rli[16];
#pragma unroll
  for (int r = 0; r < 16; ++r) rli[r] = __builtin_amdgcn_rcpf(li_l[crow(r, hi)]);
  bf16* Ow = Ob + (long)(wid * QBLK) * ldo;
#pragma unroll
  for (int r = 0; r < 16; ++r) { const int orow = crow(r, hi);
#pragma unroll
    for (int d0 = 0; d0 < 4; ++d0) Ow[(long)orow * ldo + d0 * 32 + r32] = __float2bfloat16(o[d0][r] * rli[r]); }
  __syncthreads();
#undef KPOS
#undef SLOAD
#undef SWRITE
#undef SWAIT
#undef RESC
#undef BIASM
}
#undef SBAR
}

constexpr int NWAVES = 8;
constexpr int DM = 2048, BATCH = 2, SEQ = 16384, MTOK = BATCH * SEQ, DFF = 5632, INW = 10752, MEMT = 256, MEMW = 512;
constexpr int O_QA = 0, O_KA = 1024, O_VA = 1280, O_QB = 1536, O_KB = 4608, O_VB = 7680;
constexpr float EPS = 1e-6f;
constexpr size_t MiB = 1u << 20;
constexpr size_t WS_WGU1 = 1 * MiB, WS_WD1 = WS_WGU1 + 44 * MiB, WS_WGU2 = WS_WD1 + 22 * MiB, WS_WD2 = WS_WGU2 + 44 * MiB, WS_WIN = WS_WD2 + 22 * MiB,
                 WS_WOUT = WS_WIN + 42 * MiB, WS_WQM = WS_WOUT + 8 * MiB, WS_WKVM = WS_WQM + 2 * MiB, WS_WOM = WS_WKVM + 4 * MiB, WS_HM = WS_WOM + 2 * MiB,
                 WS_KVM = WS_HM + 2 * MiB, WS_LSE = WS_KVM + 1 * MiB, WS_H = 200 * MiB, WS_PROJ = 328 * MiB, WS_END = 1000 * MiB;
static_assert(WS_LSE + 3 * MiB <= WS_H, "ws map");
constexpr size_t WS_ACT = WS_PROJ, WS_QM = WS_PROJ, WS_OM = WS_PROJ + 32 * MiB;
constexpr int RING_BYTES = 131072, LDS_BYTES = 131072 + 1024 + 2048;
constexpr int NPH = 17;

typedef unsigned short bf16r;
typedef float f32x4 __attribute__((ext_vector_type(4)));
typedef unsigned v4u __attribute__((ext_vector_type(4)));
#define LAS __attribute__((address_space(3)))

__device__ __forceinline__ unsigned f2bf(float f) { unsigned u = __builtin_bit_cast(unsigned, f); return (u + 0x7fffu + ((u >> 16) & 1u)) >> 16; }
__device__ __forceinline__ unsigned pk2(float lo, float hi) { return f2bf(lo) | (f2bf(hi) << 16); }
__device__ __forceinline__ float bf2f(unsigned short b) { return __builtin_bit_cast(float, (unsigned)b << 16); }
__device__ __forceinline__ float wave_sum(float v) {
#pragma unroll
    for (int o = 1; o < 64; o <<= 1) v += __shfl_xor(v, o);
    return v;
}
__device__ __forceinline__ void transpose_item(const float* W, int K, int N, bf16r* WT, int k0, int n0, int drow0, LAS float* scr, int lane, const float* gain) {
    { const int kr = lane >> 3, nq = lane & 7; f32x4 v[8];
#pragma unroll
      for (int i = 0; i < 8; ++i) v[i] = *(const f32x4*)(W + (size_t)(k0 + 8 * i + kr) * N + n0 + 4 * nq);
      if (gain) {
#pragma unroll
        for (int i = 0; i < 8; ++i) v[i] = v[i] * gain[k0 + 8 * i + kr]; }
#pragma unroll
      for (int i = 0; i < 8; ++i) { LAS float* d = scr + (8 * i + kr) * 33 + 4 * nq; d[0] = v[i].x; d[1] = v[i].y; d[2] = v[i].z; d[3] = v[i].w; } }
    asm volatile("s_waitcnt lgkmcnt(0)" ::: "memory");
    const int c = lane & 7;
#pragma unroll
    for (int j = 0; j < 4; ++j) { const int n = (lane >> 3) + 8 * j; const LAS float* s = scr + (8 * c) * 33 + n;
        v4u o; o.x = pk2(s[0 * 33], s[1 * 33]); o.y = pk2(s[2 * 33], s[3 * 33]); o.z = pk2(s[4 * 33], s[5 * 33]); o.w = pk2(s[6 * 33], s[7 * 33]);
        *(v4u*)(WT + (size_t)(drow0 + n) * K + k0 + 8 * c) = o; }
    asm volatile("s_waitcnt lgkmcnt(0)" ::: "memory");
}
__device__ __forceinline__ void transpose_mat(const float* W, int K, int N, bf16r* WT, int mode, int item, LAS float* scr, int lane, const float* gain = nullptr) {
    const int nblk = N / 32, kb = item / nblk, nb = item % nblk, k0 = 64 * kb, n0 = 32 * nb;
    int drow0 = n0;
    if (mode != 0) drow0 = (n0 >> 7) * 256 + (n0 & 127) + (mode == 2 ? 128 : 0);
    transpose_item(W, K, N, WT, k0, n0, drow0, scr, lane, gain);
}
__device__ __forceinline__ void rms_row_bf16(const float* xrow, const float* g, bf16r* orow, int lane) {
    const f32x4* xr = (const f32x4*)xrow + lane; f32x4 v[8]; float s = 0.f;
#pragma unroll
    for (int j = 0; j < 8; ++j) { v[j] = xr[64 * j]; s += (v[j].x * v[j].x + v[j].y * v[j].y) + (v[j].z * v[j].z + v[j].w * v[j].w); }
    const float rstd = 1.0f / sqrtf(wave_sum(s) * (1.f / DM) + EPS);
    const f32x4* gr = (const f32x4*)g + lane; unsigned long long* o8 = (unsigned long long*)orow + lane;
#pragma unroll
    for (int j = 0; j < 8; ++j) { const f32x4 gv = gr[64 * j]; const f32x4 y = v[j] * rstd * gv;
        o8[64 * j] = (unsigned long long)pk2(y.x, y.y) | ((unsigned long long)pk2(y.z, y.w) << 32); }
}
__device__ __forceinline__ void rms_row_f32(float* xrow, const float* g, int lane) {
    f32x4* xr = (f32x4*)xrow + lane; f32x4 v[8]; float s = 0.f;
#pragma unroll
    for (int j = 0; j < 8; ++j) { v[j] = xr[64 * j]; s += (v[j].x * v[j].x + v[j].y * v[j].y) + (v[j].z * v[j].z + v[j].w * v[j].w); }
    const float rstd = 1.0f / sqrtf(wave_sum(s) * (1.f / DM) + EPS);
    const f32x4* gr = (const f32x4*)g + lane;
#pragma unroll
    for (int j = 0; j < 8; ++j) { const f32x4 gv = gr[64 * j]; xr[64 * j] = v[j] * rstd * gv; }
}
__device__ __forceinline__ int t5_bucket(int rel) {
    const int n = rel < 0 ? -rel : rel; int v;
    if (n < 8) v = n; else v = 8 + (n >= 15) + (n >= 27) + (n >= 50) + (n >= 91) + (n >= 166) + (n >= 305) + (n >= 559);
    return (rel > 0 ? 16 : 0) + v;
}


#define RLX_AGENT __ATOMIC_RELAXED, __HIP_MEMORY_SCOPE_AGENT
#define XB_TMO      128
#define XB_XCNT(j)  (256  + 64 * (j))
#define XB_XSUB(j)  (1280 + 64 * (j))
#define XB_XGEN(j)  (2304 + 64 * (j))
#define XB_TOP      3328
#define XB_TOPGEN   3392
#define XCD_BAR_WORDS 3456
#define XB_SPIN_CAP (1u << 22)

__device__ __forceinline__ unsigned xb_ld(unsigned* p)              { return __hip_atomic_load(p, __ATOMIC_RELAXED, __HIP_MEMORY_SCOPE_AGENT); }
__device__ __forceinline__ unsigned xb_add(unsigned* p, unsigned v) { return __hip_atomic_fetch_add(p, v, __ATOMIC_RELAXED, __HIP_MEMORY_SCOPE_AGENT); }
__device__ __forceinline__ unsigned xb_xcc_id() { return (unsigned)__builtin_amdgcn_s_getreg((3 << 11) | 20) & 0xFu; }
#define XB_SPIN(cond, bar) do { unsigned _sp = 0; while (cond) { __builtin_amdgcn_s_sleep(1); \
    if ((++_sp & 255u) == 0u) { if (xb_ld(&(bar)[XB_TMO])) break; if (_sp > XB_SPIN_CAP) { atomicAdd(&(bar)[XB_TMO], 1u); break; } } } } while (0)

struct XcdBarrier {
    unsigned* bar; unsigned x;
    volatile LAS unsigned* st;
};

__device__ __forceinline__ XcdBarrier xcd_barrier_post(unsigned* bar, volatile LAS unsigned* st) {
    XcdBarrier b; b.bar = bar; b.x = xb_xcc_id(); b.st = st;
    if (threadIdx.x == 0) (void)xb_add(&bar[XB_XCNT(b.x)], 1u);
    return b;
}
__device__ __forceinline__ void xcd_barrier_complete(unsigned* bar, unsigned x, unsigned& nloc, unsigned& nx) {
    const unsigned G = gridDim.x * gridDim.y * gridDim.z;
    unsigned sum, cnt, mine, sp = 0u;
    for (;;) {
        sum = 0u; cnt = 0u; mine = 0u;
#pragma unroll
        for (unsigned j = 0; j < 16; ++j) { const unsigned c = xb_ld(&bar[XB_XCNT(j)]); sum += c; cnt += (c > 0u) ? 1u : 0u; mine = (j == x) ? c : mine; }
        if (sum == G) break;
        __builtin_amdgcn_s_sleep(1);
        if ((++sp & 255u) == 0u) { if (xb_ld(&bar[XB_TMO])) break; if (sp > XB_SPIN_CAP) { atomicAdd(&bar[XB_TMO], 1u); break; } }
    }
    nloc = mine > 0u ? mine : 1u; nx = cnt > 0u ? cnt : 1u;
}

__device__ __forceinline__ void xcd_barrier(const XcdBarrier& b) {
    asm volatile("s_waitcnt vmcnt(0)" ::: "memory");
    __syncthreads();
    if (threadIdx.x == 0) {
        unsigned* bar = b.bar;
        __builtin_amdgcn_s_waitcnt(0);
        unsigned nloc = b.st[0], nx = b.st[1];
        if (nloc == 0u) { xcd_barrier_complete(bar, b.x, nloc, nx); b.st[0] = nloc; b.st[1] = nx; }
        const unsigned old = xb_add(&bar[XB_XSUB(b.x)], 1u);
        const unsigned gen = old / nloc;
        if (old + 1u == (gen + 1u) * nloc) {
            __builtin_amdgcn_fence(__ATOMIC_RELEASE, "agent");
            asm volatile("s_waitcnt vmcnt(0)" ::: "memory");
            const unsigned og = xb_add(&bar[XB_TOP], 1u);
            const unsigned tg = og / nx;
            if (og + 1u == (tg + 1u) * nx) xb_add(&bar[XB_TOPGEN], 1u);
            else XB_SPIN(xb_ld(&bar[XB_TOPGEN]) == tg, bar);
            __builtin_amdgcn_fence(__ATOMIC_ACQUIRE, "agent");
            xb_add(&bar[XB_XGEN(b.x)], 1u);
            asm volatile("s_waitcnt vmcnt(0)" ::: "memory");
        } else {
            XB_SPIN(xb_ld(&bar[XB_XGEN(b.x)]) == gen, bar);
            __builtin_amdgcn_fence(__ATOMIC_ACQUIRE, "agent");
            asm volatile("s_waitcnt vmcnt(0)" ::: "memory");
        }
    }
    __syncthreads();
}

struct Args { const float* in[22]; float* out; unsigned char* ws; int ph_lo, ph_hi; };
enum { I_X = 0, I_MEM, I_F1N, I_F1G, I_F1U, I_F1D, I_MIXN, I_WIN, I_QN, I_KN, I_RELB, I_WOUT, I_MXN, I_MMN, I_WQM, I_WKVM, I_WOM, I_F2N, I_F2G, I_F2U, I_F2D, I_FIN };

__global__ void __launch_bounds__(NWAVES * 64, 2) mk_fwd(Args args) {
    extern __shared__ __attribute__((aligned(16))) unsigned char lds[];
    LAS unsigned char* ldsl = (LAS unsigned char*)lds;
    const int tid = threadIdx.x, lane = tid & 63, wave = __builtin_amdgcn_readfirstlane(tid >> 6);
    const int G = gridDim.x, bx = blockIdx.x;
    const int vcu = (G % 8 == 0) ? (bx % 8) * (G / 8) + bx / 8 : bx;
    const int gw = vcu * NWAVES + wave, NGW = G * NWAVES;
    unsigned char* ws = args.ws;
    float* out = args.out;
#define WGU1 ((bf16r*)(ws + WS_WGU1))
#define WD1 ((bf16r*)(ws + WS_WD1))
#define WGU2 ((bf16r*)(ws + WS_WGU2))
#define WD2 ((bf16r*)(ws + WS_WD2))
#define WIN ((bf16r*)(ws + WS_WIN))
#define WOUT ((bf16r*)(ws + WS_WOUT))
#define WQM ((bf16r*)(ws + WS_WQM))
#define WKVM ((bf16r*)(ws + WS_WKVM))
#define WOM ((bf16r*)(ws + WS_WOM))
#define HM ((bf16r*)(ws + WS_HM))
#define KVM ((bf16r*)(ws + WS_KVM))
#define LSE ((float*)(ws + WS_LSE))
#define H ((bf16r*)(ws + WS_H))
#define PROJ ((bf16r*)(ws + WS_PROJ))
#define ACT ((bf16r*)(ws + WS_ACT))
#define QM ((bf16r*)(ws + WS_QM))
#define OM ((bf16r*)(ws + WS_OM))
#define MIX ((bf16r*)out)
#define PCNT ((unsigned*)(ws + 32768))
#define SS ((float*)(ws + 65536))
#define XB2 ((bf16r*)(ws + WS_PROJ + 64 * MiB))
    const int lo = args.ph_lo, hi = args.ph_hi;
#ifndef PH_MASK
#define PH_MASK 0x1ffff
#endif
#define IN(k) (((PH_MASK >> (k)) & 1) && lo <= (k) && (k) < hi)
    volatile LAS unsigned* MISC = (volatile LAS unsigned*)(ldsl + RING_BYTES);
    if (tid < 16) MISC[tid] = 0u;
    __syncthreads();
    unsigned* barw = (unsigned*)ws;
    XcdBarrier xb; xb.bar = barw; xb.x = 0; xb.st = MISC;
#define SEAM(k) do { if (IN(k) && IN((k) + 1) && MK_N_LAUNCHES == 1) { if ((k) == 0) { cg::this_grid().sync(); xb = xcd_barrier_post(barw, MISC); } else { xcd_barrier(xb); } } } while (0)

    if (IN(0)) {
        if (bx == 0) { for (int t = tid; t < XCD_BAR_WORDS; t += NWAVES * 64) barw[t] = 0u; }
        LAS float* scr = (LAS float*)(ldsl + wave * 16384);
        constexpr int I_FG = (DM / 64) * (DFF / 32), I_FD = (DFF / 64) * (DM / 32), I_IN = (DM / 64) * (INW / 32), I_OUT = (DM / 64) * (DM / 32),
                      I_QM = (DM / 64) * (MEMW / 32), I_KVM = (DM / 64) * (2 * MEMW / 32), I_OM = (MEMW / 64) * (DM / 32);
        constexpr int NITEMS = 4 * I_FG + 2 * I_FD + I_IN + I_OUT + I_QM + I_KVM + I_OM;
        for (int it = gw; it < NITEMS; it += NGW) {
            int r = it;
            if (r < I_FG) { transpose_mat(args.in[I_F1G], DM, DFF, WGU1, 1, r, scr, lane); continue; } r -= I_FG;
            if (r < I_FG) { transpose_mat(args.in[I_F1U], DM, DFF, WGU1, 2, r, scr, lane); continue; } r -= I_FG;
            if (r < I_FD) { transpose_mat(args.in[I_F1D], DFF, DM, WD1, 0, r, scr, lane); continue; } r -= I_FD;
            if (r < I_IN) { transpose_mat(args.in[I_WIN], DM, INW, WIN, 0, r, scr, lane, args.in[I_MIXN]); continue; } r -= I_IN;
            if (r < I_OUT) { transpose_mat(args.in[I_WOUT], DM, DM, WOUT, 0, r, scr, lane); continue; } r -= I_OUT;
            if (r < I_QM) { transpose_mat(args.in[I_WQM], DM, MEMW, WQM, 0, r, scr, lane, args.in[I_MXN]); continue; } r -= I_QM;
            if (r < I_KVM) { transpose_mat(args.in[I_WKVM], DM, 2 * MEMW, WKVM, 0, r, scr, lane); continue; } r -= I_KVM;
            if (r < I_OM) { transpose_mat(args.in[I_WOM], MEMW, DM, WOM, 0, r, scr, lane); continue; } r -= I_OM;
            if (r < I_FG) { transpose_mat(args.in[I_F2G], DM, DFF, WGU2, 1, r, scr, lane, args.in[I_F2N]); continue; } r -= I_FG;
            if (r < I_FG) { transpose_mat(args.in[I_F2U], DM, DFF, WGU2, 2, r, scr, lane, args.in[I_F2N]); continue; } r -= I_FG;
            transpose_mat(args.in[I_F2D], DFF, DM, WD2, 0, r, scr, lane);
        }
        for (int i = gw * 64 + lane; i < 4 * MTOK; i += NGW * 64) SS[i] = 0.f;
        for (int i = gw * 64 + lane; i < 128 * 64; i += NGW * 64) PCNT[i] = 0u;
        for (int m = gw; m < MTOK; m += NGW) rms_row_bf16(args.in[I_X] + (size_t)m * DM, args.in[I_F1N], H + (size_t)m * DM, lane);
        for (int m = gw; m < BATCH * MEMT; m += NGW) rms_row_bf16(args.in[I_MEM] + (size_t)m * DM, args.in[I_MMN], HM + (size_t)m * DM, lane);
        __syncthreads();
    }
    SEAM(0);
    if (IN(1)) {
        { pg8::Gemm g{H, WGU1, MTOK, 2 * DFF, DM}; pg8::StaticOrder S; S.init(MTOK, 2 * DFF, G, bx);
          pg8::EpiSwiGLU<false> E{ACT, DFF, nullptr};
          pg8::gemm_phase<pg8::EpiSwiGLU<false>, pg8::StaticOrder, false, true>(ldsl, g, S, E); }
        { pg8::Gemm g{HM, WKVM, BATCH * MEMT, 2 * MEMW, DM}; pg8::StaticOrder S; S.init(BATCH * MEMT, 2 * MEMW, G, bx);
          pg8::EpiBf16<false> E{KVM, 2 * MEMW, nullptr};
          pg8::gemm_phase<pg8::EpiBf16<false>, pg8::StaticOrder, true, true>(ldsl, g, S, E); }
    }
    SEAM(1);
    if (IN(2)) {
        pg8::Gemm g{ACT, WD1, MTOK, DM, DFF}; pg8::StaticOrder S; S.init(MTOK, DM, G, bx, 4);
        pg8::EpiRes<false, false, true> E{args.in[I_X], nullptr, nullptr, H, SS, DM, 0.5f};
        pg8::gemm_phase<pg8::EpiRes<false, false, true>, pg8::StaticOrder, true, true>(ldsl, g, S, E);
    }
    SEAM(2);
    if (IN(4)) {
        pg8::Gemm g{H, WIN, MTOK, INW, DM}; pg8::StaticOrder S; S.init(MTOK, INW, G, bx);
        pg8::EpiBf16<true> E{PROJ, INW, SS};
        pg8::gemm_phase<pg8::EpiBf16<true>, pg8::StaticOrder, false, true>(ldsl, g, S, E);
    }
    SEAM(4);
    if (IN(5)) {
        const int hh = lane >> 5, a = (lane >> 4) & 1, i = (lane & 15) * 2;
        const float invf0 = exp2f(-(float)i * 0.41524101186092029f), invf1 = exp2f(-(float)(i + 1) * 0.41524101186092029f);
        const float* qn = args.in[I_QN] + a * 64 + i; const float* kn = args.in[I_KN] + a * 64 + i;
        const float gq1a = qn[0], gq1b = qn[1], gq2a = qn[32], gq2b = qn[33], gk1a = kn[0], gk1b = kn[1], gk2a = kn[32], gk2b = kn[33];
        for (int row = gw; row < MTOK; row += NGW) {
            const int s = row & (SEQ - 1);
            const float pos = (float)(a == 0 ? (s >> 6) : (s & 63));
            const float rev0 = pos * invf0 * 0.15915494309189535f, rev1 = pos * invf1 * 0.15915494309189535f;
            const float sn0 = __builtin_amdgcn_sinf(rev0), cs0 = __builtin_amdgcn_cosf(rev0), sn1 = __builtin_amdgcn_sinf(rev1), cs1 = __builtin_amdgcn_cosf(rev1);
            unsigned* prow = (unsigned*)(PROJ + (size_t)row * INW + a * 64 + i);
#pragma unroll
            for (int it = 4; it < 5; ++it) {
                unsigned* p = prow + (it * 2 + hh) * 64;
                const unsigned u1 = p[0], u2 = p[16];
                const float x1a = __builtin_bit_cast(float, u1 << 16), x1b = __builtin_bit_cast(float, u1 & 0xffff0000u);
                const float x2a = __builtin_bit_cast(float, u2 << 16), x2b = __builtin_bit_cast(float, u2 & 0xffff0000u);
                float ss = (x1a * x1a + x1b * x1b) + (x2a * x2a + x2b * x2b);
#pragma unroll
                for (int o = 1; o < 32; o <<= 1) ss += __shfl_xor(ss, o);
                const float rstd = 1.0f / sqrtf(ss * (1.f / 128.f) + EPS);
                const bool isq = it < 4;
                const float y1a = x1a * rstd * (isq ? gq1a : gk1a), y1b = x1b * rstd * (isq ? gq1b : gk1b);
                const float y2a = x2a * rstd * (isq ? gq2a : gk2a), y2b = x2b * rstd * (isq ? gq2b : gk2b);
                p[0] = pk2(y1a * cs0 - y2a * sn0, y1b * cs1 - y2b * sn1);
                p[16] = pk2(y2a * cs0 + y1a * sn0, y2b * cs1 + y1b * sn1);
            }
        }
    }
    SEAM(5);
    if (IN(6)) {
        const att::bf16* P = (const att::bf16*)PROJ;
        int u0, ustep, uend;
        if (G % 8 == 0) { const int per = G / 8, x = vcu / per, j = vcu % per; u0 = x * 128 + j; ustep = per; uend = x * 128 + 128; }
        else { u0 = bx; ustep = G; uend = 1024; }
        float* tab = (float*)((char*)lds + att::SHM_ATTN);
        const int bper = (3072 + G - 1) / G; int gh_prev = -1;
        const int bu0 = vcu * bper, bu1 = (bu0 + bper < 3072) ? bu0 + bper : 3072;
        const int nA = (uend > u0) ? (uend - u0 + ustep - 1) / ustep : 0;
        const int bchunk = (nA > 0) ? (bper + nA - 1) / nA : bper;
        const int nBc = (bu1 > bu0) ? (bu1 - bu0 + bchunk - 1) / bchunk : 0;
        const int nsteps = 2 * (nA > nBc ? nA : nBc), par = vcu & 1;
        for (int step = 0; step < nsteps; ++step) {
            const int k = step >> 1;
            if (((step + par) & 1) == 0) {
                const int u = u0 + k * ustep;
                if (k < nA && u < uend) {
                    const int combo = u >> 8, b = combo >> 1, kvh = combo & 1, hq = kvh * 4 + ((u >> 6) & 3), qb = u & 63;
                    const size_t rowq = (size_t)b * SEQ + (size_t)qb * 256;
                    att::attn_unit<0, true>(P + rowq * INW + O_QA + hq * 128, INW, P + (size_t)b * SEQ * INW + O_KA + kvh * 128, P + (size_t)b * SEQ * INW + O_VA + kvh * 128, INW,
                                      (att::bf16*)MIX + rowq * DM + hq * 128, DM, SEQ / 64, (char*)lds, 0, 0, nullptr, nullptr, 0, args.in[I_QN], qb * 256);
                    gh_prev = -1;
                }
            } else {
                for (int u = bu0 + k * bchunk; u < bu1 && u < bu0 + (k + 1) * bchunk; ++u) {
                    const int g = u >> 10, b = (u >> 9) & 1, h = (u >> 6) & 7, idx = u & 63;
                    const int r = (g == 0) ? 1 : (g == 1 ? 4 : 16), npos = SEQ / r, nblk = npos / 256, c = idx / nblk, qb = idx % nblk, a0 = qb * 256;
                    if ((g * 8 + h) != gh_prev) { gh_prev = g * 8 + h;
                    for (int t = tid; t < att::TAB_N; t += NWAVES * 64) { const int d = t - att::TAB_PAD;
                        tab[t] = (d >= -64 && d <= 64) ? args.in[I_RELB][t5_bucket(r * d) * 24 + g * 8 + h] * (1.0f / att::SCALE) : -INFINITY; } }
                    const size_t row0 = (size_t)b * SEQ + c;
                    const long ld = (long)r * INW;
                    att::bf16* Pq = (att::bf16*)PROJ + row0 * INW + O_QB + g * 1024 + h * 128;
                    const att::bf16* Pk = P + row0 * INW + O_KB + g * 1024 + h * 128;
                    const att::bf16* Pv = P + row0 * INW + O_VB + g * 1024 + h * 128;
                    float* lse = LSE + ((size_t)g * MTOK + row0 + (size_t)a0 * r) * 8 + h;
                    att::attn_unit<1>(Pq + (long)a0 * ld, ld, Pk, Pv, ld, Pq + (long)a0 * ld, ld, 6, (char*)lds, a0 - 64, npos, tab, lse, (long)r * 8);
                }
            }
        }
    }
    SEAM(6);
    if (IN(7)) {
        for (int m = gw; m < MTOK; m += NGW) {
#pragma unroll
            for (int j = 0; j < 2; ++j) {
                const int e = j * 512 + lane * 8, h = e >> 7;
                const float l0 = LSE[((size_t)0 * MTOK + m) * 8 + h], l1 = LSE[((size_t)1 * MTOK + m) * 8 + h], l2 = LSE[((size_t)2 * MTOK + m) * 8 + h];
                const float mx = fmaxf(l0, fmaxf(l1, l2)); float w0 = __expf(l0 - mx), w1 = __expf(l1 - mx), w2 = __expf(l2 - mx);
                const float inv = 1.0f / (w0 + w1 + w2); w0 *= inv; w1 *= inv; w2 *= inv;
                const bf16r* p = PROJ + (size_t)m * INW + O_QB + e;
                const v4u a0 = *(const v4u*)p, a1 = *(const v4u*)(p + 1024), a2 = *(const v4u*)(p + 2048);
                v4u o;
#pragma unroll
                for (int q = 0; q < 4; ++q) {
                    const float x0 = __builtin_bit_cast(float, a0[q] << 16), y0 = __builtin_bit_cast(float, a0[q] & 0xffff0000u);
                    const float x1 = __builtin_bit_cast(float, a1[q] << 16), y1 = __builtin_bit_cast(float, a1[q] & 0xffff0000u);
                    const float x2 = __builtin_bit_cast(float, a2[q] << 16), y2 = __builtin_bit_cast(float, a2[q] & 0xffff0000u);
                    o[q] = pk2(w0 * x0 + w1 * x1 + w2 * x2, w0 * y0 + w1 * y1 + w2 * y2);
                }
                *(v4u*)(MIX + (size_t)m * DM + 1024 + e) = o;
            }
        }
    }
    SEAM(7);
    if (IN(8)) {
        pg8::Gemm g{MIX, WOUT, MTOK, DM, DM}; pg8::StaticOrder S; S.init(MTOK, DM, G, bx, 4);
        pg8::EpiRes<true, false, true> E{nullptr, H, nullptr, XB2, SS + MTOK, DM, 1.0f};
        pg8::gemm_phase<pg8::EpiRes<true, false, true>, pg8::StaticOrder, true, true>(ldsl, g, S, E);
    }
    SEAM(8);
    if (IN(10)) {
        pg8::Gemm g{XB2, WQM, MTOK, MEMW, DM}; pg8::StaticOrder S; S.init(MTOK, MEMW, G, bx);
        pg8::EpiBf16<true> E{QM, MEMW, SS + MTOK};
        pg8::gemm_phase<pg8::EpiBf16<true>, pg8::StaticOrder, false, true>(ldsl, g, S, E);
    }
    SEAM(10);
    if (IN(11)) {
        for (int u = vcu; u < 512; u += G) {
            const int qb = u >> 2, h = u & 3; const size_t rowq = (size_t)qb * 256; const int b = (int)(rowq / SEQ);
            const att::bf16* kv = (const att::bf16*)KVM + (size_t)b * MEMT * (2 * MEMW);
            att::attn_unit<0>((const att::bf16*)QM + rowq * MEMW + h * 128, MEMW, kv + h * 128, kv + MEMW + h * 128, 2 * MEMW,
                              (att::bf16*)OM + rowq * MEMW + h * 128, MEMW, MEMT / 64, (char*)lds, 0, 0, nullptr, nullptr, 0);
        }
    }
    SEAM(11);
    if (IN(12)) {
        pg8::Gemm g{OM, WOM, MTOK, DM, MEMW}; pg8::StaticOrder S; S.init(MTOK, DM, G, bx, 4);
        pg8::EpiRes<true, false, true> E{nullptr, XB2, nullptr, H, SS + 2 * MTOK, DM, 1.0f};
        pg8::gemm_phase<pg8::EpiRes<true, false, true>, pg8::StaticOrder, true, true>(ldsl, g, S, E);
    }
    SEAM(12);
    if (IN(14)) {
        pg8::Gemm g{H, WGU2, MTOK, 2 * DFF, DM}; pg8::StaticOrder S; S.init(MTOK, 2 * DFF, G, bx);
        pg8::EpiSwiGLU<true> E{ACT, DFF, SS + 2 * MTOK};
        pg8::gemm_phase<pg8::EpiSwiGLU<true>, pg8::StaticOrder, false, true>(ldsl, g, S, E);
    }
    SEAM(14);
    if (IN(15)) {
        pg8::Gemm g{ACT, WD2, MTOK, DM, DFF}; pg8::StaticOrder S; S.init(MTOK, DM, G, bx, 4);
        pg8::EpiFinal E{H, out, SS + 3 * MTOK, PCNT, args.in[I_FIN], DM, 0.5f, (unsigned)(DM / 256)};
        pg8::gemm_phase<pg8::EpiFinal, pg8::StaticOrder, true, true>(ldsl, g, S, E);
    }
#undef IN
#undef SEAM
}

extern "C" void kernel_launch(void* const* d_in, const int* in_sizes, int n_in, void* d_out, int out_size, void* d_ws, size_t ws_size, hipStream_t stream) {
    static int grid = 0;
    if (grid == 0) {
        if (n_in != 22 || in_sizes[0] != MTOK * DM || out_size != MTOK * DM || ws_size < WS_END) {
            fprintf(stderr, "kernel_launch: unexpected shapes: n_in %d in0 %d out %d ws %zu (need >= %zu)\n", n_in, n_in > 0 ? in_sizes[0] : -1, out_size, ws_size, (size_t)WS_END); grid = -1; return; }
        int dev = 0, cus = 0, per_cu = 0;
        if (hipGetDevice(&dev) != hipSuccess || hipDeviceGetAttribute(&cus, hipDeviceAttributeMultiprocessorCount, dev) != hipSuccess) { fprintf(stderr, "kernel_launch: device query failed\n"); grid = -1; return; }
        if (hipFuncSetAttribute((const void*)mk_fwd, hipFuncAttributeMaxDynamicSharedMemorySize, LDS_BYTES) != hipSuccess) { fprintf(stderr, "kernel_launch: hipFuncSetAttribute failed\n"); grid = -1; return; }
        if (hipOccupancyMaxActiveBlocksPerMultiprocessor(&per_cu, (const void*)mk_fwd, NWAVES * 64, LDS_BYTES) != hipSuccess || per_cu < 1) { fprintf(stderr, "kernel_launch: occupancy query gave %d\n", per_cu); per_cu = 1; }
        (void)hipGetLastError();
        grid = cus * 1;
        fprintf(stderr, "kernel_launch: grid %d (cus %d, per_cu %d)\n", grid, cus, per_cu);
    }
    if (grid < 0) return;
    Args a{};
    for (int i = 0; i < 22; ++i) a.in[i] = (const float*)d_in[i];
    a.out = (float*)d_out; a.ws = (unsigned char*)d_ws;
    if (MK_N_LAUNCHES == 1) {
        a.ph_lo = 0; a.ph_hi = NPH;
        void* kargs[] = {&a};
        hipError_t e = hipLaunchCooperativeKernel((const void*)mk_fwd, dim3(grid), dim3(NWAVES * 64), kargs, LDS_BYTES, stream);
        if (e != hipSuccess) fprintf(stderr, "kernel_launch: cooperative launch failed: %s (grid %d)\n", hipGetErrorString(e), grid);
    } else {
        for (int p = 0; p < NPH; ++p) {
            a.ph_lo = p; a.ph_hi = p + 1;
            hipLaunchKernelGGL(mk_fwd, dim3(grid), dim3(NWAVES * 64), LDS_BYTES, stream, a);
        }
        hipError_t e = hipPeekAtLastError();
        if (e != hipSuccess) fprintf(stderr, "kernel_launch: launch failed: %s\n", hipGetErrorName(e));
    }
}
```

```cpp
#include <hip/hip_runtime.h>
#include <hip/hip_bf16.h>
#include <hip/hip_cooperative_groups.h>
#include <cstdio>
#include <cstdint>
#include <cmath>
namespace cg = cooperative_groups;

#ifndef ATT_SD0
#define ATT_SD0 2
#endif
#ifndef MK_N_LAUNCHES
#define MK_N_LAUNCHES 1
#endif

namespace pg8 {
#define PG8_LAS __attribute__((address_space(3)))
typedef unsigned short bf16_t;
typedef short bf16x8 __attribute__((ext_vector_type(8)));
typedef float f32x4 __attribute__((ext_vector_type(4)));
typedef unsigned u32x4 __attribute__((ext_vector_type(4)));
constexpr int BM = 256, BK = 64, HALF = 128, HTB = HALF * BK * 2, STAGE_BYTES = 8 * HTB, NXCD = 8, WGM = 8;

__host__ __device__ __forceinline__ int lds_byte(int r, int c) { const int st = (r >> 4) * 2 + (c >> 5), rr = r & 15, cc = c & 31, ob = rr * 64 + cc * 2; return st * 1024 + (ob ^ (((ob >> 9) & 1) << 5)); }
__host__ __device__ __forceinline__ void stage_rc(int b, int& R, int& C) { const int st = b / 1024, sb = b % 1024, swz = sb ^ (((sb >> 9) & 1) << 5); R = (st >> 1) * 16 + swz / 64; C = (st & 1) * 32 + (swz % 64) / 2; }
__host__ __device__ __forceinline__ int perm32(int rho) { const int n = rho >> 4, i = rho & 15; return 8 * (i >> 2) + 4 * n + (i & 3); }

struct Unit { int pm, pn; };
struct Gemm { const bf16_t* A; const bf16_t* Bt; int M, N, K; };

struct StaticOrder {
    int nM, nN, nwg, G, c, wgm;
    __host__ __device__ void init(int M, int N, int G_, int c_, int wgm_ = WGM) { nM = M / BM; nN = N / BM; nwg = nM * nN; G = G_; c = c_; wgm = wgm_; }
    __host__ __device__ bool next(int i, Unit& u) const {
        const long L = (long)i * G + c; if (L >= nwg) return false;
        int wgid = (int)L; { const int q = nwg / NXCD, r = nwg % NXCD, xcd = wgid % NXCD, off = wgid / NXCD; wgid = (xcd < r ? xcd * (q + 1) : r * (q + 1) + (xcd - r) * q) + off; }
        const int nig = wgm * nN, gid = wgid / nig, fm = gid * wgm, gsz = (nM - fm) < wgm ? (nM - fm) : wgm;
        u.pm = fm + ((wgid % nig) % gsz); u.pn = (wgid % nig) / gsz; return true;
    }
    __device__ __forceinline__ void a_ready(const Unit&) const {}
    __device__ __forceinline__ void done(const Unit&) const {}
};

__device__ __forceinline__ unsigned cvt_pk_bf16(float lo, float hi) { unsigned r; asm volatile("v_cvt_pk_bf16_f32 %0, %1, %2" : "=v"(r) : "v"(lo), "v"(hi)); return r; }

template <bool NORM> struct EpiBf16 {
    static constexpr bool PERM = true, AFTER_DRAIN = false;
    bf16_t* O; int ldc; const float* ss;
    __device__ __forceinline__ void operator()(const f32x4 (&acc)[2][2][4][2], const Unit& u, int wr, int wc, int fr, int fq) const {
        const int row0 = u.pm * BM + wr * 64 + fr; const int col0 = u.pn * BM + wc * 32 + 8 * fq;
#pragma unroll
        for (int ai = 0; ai < 2; ++ai)
#pragma unroll
            for (int m = 0; m < 4; ++m) { const int row = row0 + ai * HALF + m * 16; bf16_t* rowp = O + (size_t)row * ldc + col0;
                float rs = 1.0f; if constexpr (NORM) rs = 1.0f / sqrtf(ss[row] * (1.0f / 2048.0f) + 1e-6f);
#pragma unroll
                for (int bj = 0; bj < 2; ++bj) { const f32x4 v0 = acc[ai][bj][m][0] * rs, v1 = acc[ai][bj][m][1] * rs;
                    u32x4 w; w.x = cvt_pk_bf16(v0[0], v0[1]); w.y = cvt_pk_bf16(v0[2], v0[3]); w.z = cvt_pk_bf16(v1[0], v1[1]); w.w = cvt_pk_bf16(v1[2], v1[3]);
                    *(u32x4*)(rowp + bj * HALF) = w; } }
    }
};
template <bool NORM> struct EpiSwiGLU {
    static constexpr bool PERM = true, AFTER_DRAIN = false;
    bf16_t* O; int ldc; const float* ss;
    __device__ __forceinline__ float act(float g, float u) const { const float e = __builtin_amdgcn_exp2f(-g * 1.4426950408889634f); return g * u * __builtin_amdgcn_rcpf(1.0f + e); }
    __device__ __forceinline__ void operator()(const f32x4 (&acc)[2][2][4][2], const Unit& u, int wr, int wc, int fr, int fq) const {
        const int row0 = u.pm * BM + wr * 64 + fr; const int col0 = u.pn * HALF + wc * 32 + 8 * fq;
#pragma unroll
        for (int ai = 0; ai < 2; ++ai)
#pragma unroll
            for (int m = 0; m < 4; ++m) { const int row = row0 + ai * HALF + m * 16; bf16_t* rowp = O + (size_t)row * ldc + col0;
                float rs = 1.0f; if constexpr (NORM) rs = 1.0f / sqrtf(ss[row] * (1.0f / 2048.0f) + 1e-6f);
                const f32x4 g0 = acc[ai][0][m][0] * rs, g1 = acc[ai][0][m][1] * rs, u0 = acc[ai][1][m][0] * rs, u1 = acc[ai][1][m][1] * rs;
                u32x4 w; w.x = cvt_pk_bf16(act(g0[0], u0[0]), act(g0[1], u0[1])); w.y = cvt_pk_bf16(act(g0[2], u0[2]), act(g0[3], u0[3]));
                w.z = cvt_pk_bf16(act(g1[0], u1[0]), act(g1[1], u1[1])); w.w = cvt_pk_bf16(act(g1[2], u1[2]), act(g1[3], u1[3]));
                *(u32x4*)rowp = w; }
    }
};
template <bool BASE_BF16, bool WRITE_F32, bool WRITE_XB> struct EpiRes {
    static constexpr bool PERM = true, AFTER_DRAIN = false;
    const float* base; const bf16_t* baseb; float* out; bf16_t* xb; float* ss; int ldc; float alpha;
    __device__ __forceinline__ void operator()(const f32x4 (&acc)[2][2][4][2], const Unit& u, int wr, int wc, int fr, int fq) const {
        const int row0 = u.pm * BM + wr * 64 + fr; const int col0 = u.pn * BM + wc * 32 + 8 * fq;
#pragma unroll
        for (int ai = 0; ai < 2; ++ai)
#pragma unroll
            for (int m = 0; m < 4; ++m) { const int row = row0 + ai * HALF + m * 16; const size_t off = (size_t)row * ldc + col0; float part = 0.f;
#pragma unroll
                for (int bj = 0; bj < 2; ++bj) { const size_t idx = off + bj * HALF;
                    f32x4 b0, b1;
                    if constexpr (BASE_BF16) { const u32x4 r = *(const u32x4*)(baseb + idx);
                        b0 = (f32x4){__builtin_bit_cast(float, r.x << 16), __builtin_bit_cast(float, r.x & 0xffff0000u), __builtin_bit_cast(float, r.y << 16), __builtin_bit_cast(float, r.y & 0xffff0000u)};
                        b1 = (f32x4){__builtin_bit_cast(float, r.z << 16), __builtin_bit_cast(float, r.z & 0xffff0000u), __builtin_bit_cast(float, r.w << 16), __builtin_bit_cast(float, r.w & 0xffff0000u)}; }
                    else { b0 = *(const f32x4*)(base + idx); b1 = *(const f32x4*)(base + idx + 4); }
                    const f32x4 o0 = b0 + acc[ai][bj][m][0] * alpha, o1 = b1 + acc[ai][bj][m][1] * alpha;
                    if constexpr (WRITE_F32) { *(f32x4*)(out + idx) = o0; *(f32x4*)(out + idx + 4) = o1; }
                    if constexpr (WRITE_XB) {
                        part += (o0[0] * o0[0] + o0[1] * o0[1]) + (o0[2] * o0[2] + o0[3] * o0[3]) + (o1[0] * o1[0] + o1[1] * o1[1]) + (o1[2] * o1[2] + o1[3] * o1[3]);
                        u32x4 w; w.x = cvt_pk_bf16(o0[0], o0[1]); w.y = cvt_pk_bf16(o0[2], o0[3]); w.z = cvt_pk_bf16(o1[0], o1[1]); w.w = cvt_pk_bf16(o1[2], o1[3]);
                        *(u32x4*)(xb + idx) = w; } }
                if constexpr (WRITE_XB) { part += __shfl_xor(part, 16); part += __shfl_xor(part, 32);
                    if (fq == 0) atomicAdd(ss + row, part); } }
    }
};
struct EpiFinal {
    static constexpr bool PERM = true, AFTER_DRAIN = false;
    const bf16_t* baseb; float* out; float* ss; unsigned* cnt; const float* gain; int ldc; float alpha; unsigned ntn;
    __device__ __forceinline__ void tile(const f32x4 (&acc)[2][2][4][2], int ai, int m, int bj, size_t idx, f32x4& o0, f32x4& o1) const {
        const u32x4 r = *(const u32x4*)(baseb + idx);
        const f32x4 b0 = (f32x4){__builtin_bit_cast(float, r.x << 16), __builtin_bit_cast(float, r.x & 0xffff0000u), __builtin_bit_cast(float, r.y << 16), __builtin_bit_cast(float, r.y & 0xffff0000u)};
        const f32x4 b1 = (f32x4){__builtin_bit_cast(float, r.z << 16), __builtin_bit_cast(float, r.z & 0xffff0000u), __builtin_bit_cast(float, r.w << 16), __builtin_bit_cast(float, r.w & 0xffff0000u)};
        o0 = b0 + acc[ai][bj][m][0] * alpha; o1 = b1 + acc[ai][bj][m][1] * alpha;
    }
    __device__ __forceinline__ void operator()(const f32x4 (&acc)[2][2][4][2], const Unit& u, int wr, int wc, int fr, int fq) const {
        const int row0 = u.pm * BM + wr * 64 + fr; const int col0 = u.pn * BM + wc * 32 + 8 * fq;
#pragma unroll
        for (int ai = 0; ai < 2; ++ai)
#pragma unroll
            for (int m = 0; m < 4; ++m) { const int row = row0 + ai * HALF + m * 16; const size_t off = (size_t)row * ldc + col0; float part = 0.f;
#pragma unroll
                for (int bj = 0; bj < 2; ++bj) { f32x4 o0, o1; tile(acc, ai, m, bj, off + bj * HALF, o0, o1);
                    part += (o0[0] * o0[0] + o0[1] * o0[1]) + (o0[2] * o0[2] + o0[3] * o0[3]) + (o1[0] * o1[0] + o1[1] * o1[1]) + (o1[2] * o1[2] + o1[3] * o1[3]); }
                part += __shfl_xor(part, 16); part += __shfl_xor(part, 32);
                if (fq == 0) atomicAdd(ss + row, part); }
        asm volatile("s_waitcnt vmcnt(0)" ::: "memory");
        __builtin_amdgcn_s_barrier();
        if (threadIdx.x == 0) {
            unsigned* c = cnt + 64 * u.pm;
            __hip_atomic_fetch_add(c, 1u, __ATOMIC_RELAXED, __HIP_MEMORY_SCOPE_AGENT);
            unsigned sp = 0;
            while (__hip_atomic_load(c, __ATOMIC_RELAXED, __HIP_MEMORY_SCOPE_AGENT) < ntn) { __builtin_amdgcn_s_sleep(2); if (++sp > (1u << 22)) break; }
        }
        asm volatile("s_waitcnt vmcnt(0) lgkmcnt(0)" ::: "memory");
        __builtin_amdgcn_s_barrier(); asm volatile("" ::: "memory");
        f32x4 gv[2][2];
#pragma unroll
        for (int bj = 0; bj < 2; ++bj) { gv[bj][0] = *(const f32x4*)(gain + col0 + bj * HALF); gv[bj][1] = *(const f32x4*)(gain + col0 + bj * HALF + 4); }
#pragma unroll
        for (int ai = 0; ai < 2; ++ai)
#pragma unroll
            for (int m = 0; m < 4; ++m) { const int row = row0 + ai * HALF + m * 16; const size_t off = (size_t)row * ldc + col0;
                const float sv = __hip_atomic_load(ss + row, __ATOMIC_RELAXED, __HIP_MEMORY_SCOPE_AGENT);
                const float rs = 1.0f / sqrtf(sv * (1.0f / 2048.0f) + 1e-6f);
#pragma unroll
                for (int bj = 0; bj < 2; ++bj) { f32x4 o0, o1; const size_t idx = off + bj * HALF; tile(acc, ai, m, bj, idx, o0, o1);
                    *(f32x4*)(out + idx) = o0 * rs * gv[bj][0]; *(f32x4*)(out + idx + 4) = o1 * rs * gv[bj][1]; } }
    }
};
struct EpiResidX {
    static constexpr bool PERM = true, AFTER_DRAIN = false;
    const float* base; float* out; bf16_t* xb; float* ss; int ldc; float alpha;
    __device__ __forceinline__ void operator()(const f32x4 (&acc)[2][2][4][2], const Unit& u, int wr, int wc, int fr, int fq) const {
        const int row0 = u.pm * BM + wr * 64 + fr; const int col0 = u.pn * BM + wc * 32 + 8 * fq;
#pragma unroll
        for (int ai = 0; ai < 2; ++ai)
#pragma unroll
            for (int m = 0; m < 4; ++m) { const int row = row0 + ai * HALF + m * 16; const size_t off = (size_t)row * ldc + col0; float part = 0.f;
#pragma unroll
                for (int bj = 0; bj < 2; ++bj) { const size_t idx = off + bj * HALF;
                    const f32x4 b0 = *(const f32x4*)(base + idx), b1 = *(const f32x4*)(base + idx + 4);
                    const f32x4 o0 = b0 + acc[ai][bj][m][0] * alpha, o1 = b1 + acc[ai][bj][m][1] * alpha;
                    *(f32x4*)(out + idx) = o0; *(f32x4*)(out + idx + 4) = o1;
                    part += (o0[0] * o0[0] + o0[1] * o0[1]) + (o0[2] * o0[2] + o0[3] * o0[3]) + (o1[0] * o1[0] + o1[1] * o1[1]) + (o1[2] * o1[2] + o1[3] * o1[3]);
                    u32x4 w; w.x = cvt_pk_bf16(o0[0], o0[1]); w.y = cvt_pk_bf16(o0[2], o0[3]); w.z = cvt_pk_bf16(o1[0], o1[1]); w.w = cvt_pk_bf16(o1[2], o1[3]);
                    *(u32x4*)(xb + idx) = w; }
                part += __shfl_xor(part, 16); part += __shfl_xor(part, 32);
                if (fq == 0) atomicAdd(ss + row, part); }
    }
};
struct EpiResid {
    static constexpr bool PERM = false, AFTER_DRAIN = false;
    const float* base; float* out; int ldc; float alpha;
    __device__ __forceinline__ void operator()(const f32x4 (&acc)[2][2][4][2], const Unit& u, int wr, int wc, int fr, int fq) const {
        const int row0 = u.pm * BM + wr * 64 + fr; const int col0 = u.pn * BM + wc * 32 + 4 * fq;
#pragma unroll
        for (int ai = 0; ai < 2; ++ai)
#pragma unroll
            for (int m = 0; m < 4; ++m) { const size_t off = (size_t)(row0 + ai * HALF + m * 16) * ldc + col0;
#pragma unroll
                for (int bj = 0; bj < 2; ++bj)
#pragma unroll
                    for (int n = 0; n < 2; ++n) { const size_t idx = off + bj * HALF + n * 16; const f32x4 b = *(const f32x4*)(base + idx);
                        *(f32x4*)(out + idx) = b + acc[ai][bj][m][n] * alpha; } }
    }
};

template <class Epi, class Sched, bool ALIGN_EPI = false, bool SP2 = false>
__device__ __forceinline__ void gemm_phase(PG8_LAS unsigned char* lds, const Gemm g, const Sched& S, const Epi& E) {
    int tid = threadIdx.x; asm volatile("" : "+v"(tid));
    const int wid = __builtin_amdgcn_readfirstlane(tid >> 6), lane = tid & 63, wr = wid >> 2, wc = wid & 3, fr = lane & 15, fq = lane >> 4;
    const int K = g.K, nt = K / BK;
    unsigned voffA[2], voffB[2];
#pragma unroll
    for (int i = 0; i < 2; ++i) { int R, C; stage_rc(tid * 16 + i * 8192, R, C); const int Rb = Epi::PERM ? ((R & ~31) + perm32(R & 31)) : R;
        voffA[i] = (unsigned)(R * K + C) * 2u; voffB[i] = (unsigned)(Rb * K + C) * 2u; }
    const size_t kstep = (size_t)(BK * 2);
    const size_t hstep = (size_t)HALF * K * 2;
    const size_t tstep = 2 * hstep;
    const unsigned ldsw = (unsigned)wid * 1024u;
    const int aoff = lds_byte(wr * 64 + fr, fq * 8), boff = lds_byte(wc * 32 + fr, fq * 8);
#define PG8_SA(b, h) (((b) * 2 + (h)) * HTB)
#define PG8_SB(b, h) ((4 + (b) * 2 + (h)) * HTB)
#define PG8_STAGE(bufoff, gbase, voff) do { _Pragma("unroll") for (int _i = 0; _i < 2; ++_i) \
        __builtin_amdgcn_global_load_lds((const unsigned*)((const char*)(gbase) + (voff)[_i]), (PG8_LAS unsigned*)(lds + (bufoff) + ldsw + _i * 8192), 16, 0, 0); } while (0)
#define PG8_LDA(dst, b, h) do { _Pragma("unroll") for (int m = 0; m < 4; ++m) _Pragma("unroll") for (int k = 0; k < 2; ++k) dst[m][k] = *(const PG8_LAS bf16x8*)(lds + PG8_SA(b, h) + aoff + m * 2048 + k * 1024); } while (0)
#define PG8_LDB(dst, b, h) do { _Pragma("unroll") for (int n = 0; n < 2; ++n) _Pragma("unroll") for (int k = 0; k < 2; ++k) dst[n][k] = *(const PG8_LAS bf16x8*)(lds + PG8_SB(b, h) + boff + n * 2048 + k * 1024); } while (0)
#define PG8_MMA(ai, bj, At, Bt) do { __builtin_amdgcn_s_setprio(1); _Pragma("unroll") for (int m = 0; m < 4; ++m) _Pragma("unroll") for (int n = 0; n < 2; ++n) _Pragma("unroll") for (int k = 0; k < 2; ++k) \
        acc[ai][bj][m][n] = __builtin_amdgcn_mfma_f32_16x16x32_bf16(Bt[n][k], At[m][k], acc[ai][bj][m][n], 0, 0, 0); __builtin_amdgcn_s_setprio(0); } while (0)
#define PG8_WAIT_V(n) asm volatile("s_waitcnt vmcnt(" #n ")" ::: "memory")
#define PG8_WAIT_L(n) asm volatile("s_waitcnt lgkmcnt(" #n ")" ::: "memory")
#define PG8_BAR __builtin_amdgcn_s_barrier()
#define PG8_SCHED __builtin_amdgcn_sched_barrier(0)
    Unit cur, nxt; int ui = 0;
    if (!S.next(0, cur)) return;
    f32x4 acc[2][2][4][2];
#pragma unroll
    for (int a = 0; a < 2; ++a)
#pragma unroll
        for (int b = 0; b < 2; ++b)
#pragma unroll
            for (int m = 0; m < 4; ++m)
#pragma unroll
                for (int n = 0; n < 2; ++n) acc[a][b][m][n] = (f32x4){0.f, 0.f, 0.f, 0.f};
    bf16x8 At[4][2], B0[2][2], B1[2][2];
    const char* cA = (const char*)g.A + (size_t)cur.pm * tstep; const char* cB = (const char*)g.Bt + (size_t)cur.pn * tstep;
    S.a_ready(cur);
    if constexpr (SP2) {
        PG8_STAGE(PG8_SB(0, 0), cB, voffB); PG8_STAGE(PG8_SB(0, 1), cB + hstep, voffB); PG8_STAGE(PG8_SA(0, 0), cA, voffA); PG8_STAGE(PG8_SA(0, 1), cA + hstep, voffA);
        if (wr == 1) PG8_BAR;
        PG8_WAIT_V(2); PG8_BAR;
        PG8_STAGE(PG8_SB(1, 0), cB + kstep, voffB); PG8_STAGE(PG8_SA(1, 0), cA + kstep, voffA); PG8_STAGE(PG8_SB(1, 1), cB + hstep + kstep, voffB);
        PG8_WAIT_V(6); PG8_BAR;
    } else {
        PG8_STAGE(PG8_SB(0, 0), cB, voffB); PG8_STAGE(PG8_SA(0, 0), cA, voffA); PG8_STAGE(PG8_SB(0, 1), cB + hstep, voffB); PG8_STAGE(PG8_SA(0, 1), cA + hstep, voffA);
        if (wr == 1) PG8_BAR;
        PG8_WAIT_V(4); PG8_BAR;
        PG8_STAGE(PG8_SB(1, 0), cB + kstep, voffB); PG8_STAGE(PG8_SA(1, 0), cA + kstep, voffA); PG8_STAGE(PG8_SB(1, 1), cB + hstep + kstep, voffB);
        PG8_WAIT_V(6); PG8_BAR;
    }
    for (;;) {
        const bool has_next = S.next(ui + 1, nxt);
        const char* nA = has_next ? (const char*)g.A + (size_t)nxt.pm * tstep : cA; const char* nB = has_next ? (const char*)g.Bt + (size_t)nxt.pn * tstep : cB;
        for (int t = 0; t < nt; t += 2) {
            const bool last = (t == nt - 2);
            const char* a1 = cA + (size_t)(t + 1) * kstep;
            const char* a2 = last ? nA : cA + (size_t)(t + 2) * kstep; const char* b2 = last ? nB : cB + (size_t)(t + 2) * kstep;
            const char* a3 = a2 + kstep; const char* b3 = b2 + kstep;
            if (last && has_next) S.a_ready(nxt);
            if constexpr (SP2) {
            PG8_LDB(B0, 0, 0); PG8_LDB(B1, 0, 1); PG8_SCHED; PG8_LDA(At, 0, 0); PG8_STAGE(PG8_SA(1, 1), a1 + hstep, voffA);
            PG8_WAIT_V(8); PG8_WAIT_L(0); PG8_BAR; PG8_MMA(0, 0, At, B0); PG8_MMA(0, 1, At, B1); PG8_BAR; PG8_SCHED;
            PG8_LDA(At, 0, 1); PG8_STAGE(PG8_SB(0, 0), b2, voffB); PG8_STAGE(PG8_SB(0, 1), b2 + hstep, voffB); PG8_STAGE(PG8_SA(0, 0), a2, voffA);
            PG8_WAIT_V(8); PG8_WAIT_L(0); PG8_BAR; PG8_MMA(1, 0, At, B0); PG8_MMA(1, 1, At, B1); PG8_BAR; PG8_SCHED;
            PG8_LDB(B0, 1, 0); PG8_LDB(B1, 1, 1); PG8_SCHED; PG8_LDA(At, 1, 0); PG8_STAGE(PG8_SA(0, 1), a2 + hstep, voffA);
            PG8_WAIT_V(8); PG8_WAIT_L(0); PG8_BAR; PG8_MMA(0, 0, At, B0); PG8_MMA(0, 1, At, B1); PG8_BAR; PG8_SCHED;
            PG8_LDA(At, 1, 1); PG8_STAGE(PG8_SB(1, 0), b3, voffB); PG8_STAGE(PG8_SB(1, 1), b3 + hstep, voffB); PG8_STAGE(PG8_SA(1, 0), a3, voffA);
            PG8_WAIT_V(8); PG8_WAIT_L(0); PG8_BAR; PG8_MMA(1, 0, At, B0); PG8_MMA(1, 1, At, B1); PG8_BAR; PG8_SCHED;
            } else {
            PG8_LDB(B0, 0, 0); PG8_SCHED; PG8_LDA(At, 0, 0); PG8_STAGE(PG8_SA(1, 1), a1 + hstep, voffA);
            PG8_WAIT_L(8); PG8_BAR; PG8_WAIT_L(0); PG8_MMA(0, 0, At, B0); PG8_BAR; PG8_SCHED;
            PG8_LDB(B1, 0, 1); PG8_STAGE(PG8_SB(0, 0), b2, voffB);
            PG8_BAR; PG8_WAIT_L(0); PG8_MMA(0, 1, At, B1); PG8_BAR;
            PG8_LDA(At, 0, 1); PG8_STAGE(PG8_SA(0, 0), a2, voffA);
            PG8_BAR; PG8_WAIT_L(0); PG8_MMA(1, 0, At, B0); PG8_BAR; PG8_SCHED;
            PG8_STAGE(PG8_SB(0, 1), b2 + hstep, voffB);
            PG8_WAIT_V(6); PG8_BAR; PG8_MMA(1, 1, At, B1); PG8_BAR;
            PG8_LDB(B0, 1, 0); PG8_SCHED; PG8_LDA(At, 1, 0); PG8_STAGE(PG8_SA(0, 1), a2 + hstep, voffA);
            PG8_WAIT_L(8); PG8_BAR; PG8_WAIT_L(0); PG8_MMA(0, 0, At, B0); PG8_BAR; PG8_SCHED;
            PG8_LDB(B1, 1, 1); PG8_STAGE(PG8_SB(1, 0), b3, voffB);
            PG8_BAR; PG8_WAIT_L(0); PG8_MMA(0, 1, At, B1); PG8_BAR;
            PG8_LDA(At, 1, 1); PG8_STAGE(PG8_SA(1, 0), a3, voffA);
            PG8_BAR; PG8_WAIT_L(0); PG8_MMA(1, 0, At, B0); PG8_BAR; PG8_SCHED;
            PG8_STAGE(PG8_SB(1, 1), b3 + hstep, voffB);
            PG8_WAIT_V(6); PG8_BAR; PG8_MMA(1, 1, At, B1); PG8_BAR;
            }
        }
        if constexpr (ALIGN_EPI) { if (wr == 0) PG8_BAR; }
        if constexpr (!Epi::AFTER_DRAIN) { E(acc, cur, wr, wc, fr, fq); S.done(cur); }
        if (!has_next) break;
#pragma unroll
        for (int a = 0; a < 2; ++a)
#pragma unroll
            for (int b = 0; b < 2; ++b)
#pragma unroll
                for (int m = 0; m < 4; ++m)
#pragma unroll
                    for (int n = 0; n < 2; ++n) acc[a][b][m][n] = (f32x4){0.f, 0.f, 0.f, 0.f};
        cur = nxt; cA = nA; cB = nB; ++ui;
        if constexpr (ALIGN_EPI) { if (wr == 1) PG8_BAR; }
    }
    PG8_WAIT_V(0);
    if constexpr (!ALIGN_EPI) { if (wr == 0) PG8_BAR; }
    PG8_BAR;
#undef PG8_SA
#undef PG8_SB
#undef PG8_STAGE
#undef PG8_LDA
#undef PG8_LDB
#undef PG8_MMA
#undef PG8_WAIT_V
#undef PG8_WAIT_L
#undef PG8_BAR
#undef PG8_SCHED
}
}

namespace att {
using bf16 = __hip_bfloat16;
constexpr int D = 128, NW = 8, QBLK = 32, KVBLK = 64;
constexpr float SCALE = 0.088388347648318440f;
constexpr float THR = 8.f;
constexpr size_t SHM_V = KVBLK * D * 2, SHM_K = KVBLK * D * 2, SHM_ATTN = 2 * SHM_V + 2 * SHM_K + NW * 64 * 4;
constexpr int TAB_N = 640, TAB_PAD = 320;
using bf16x8 = __attribute__((ext_vector_type(8))) short;
using s16x4  = __attribute__((ext_vector_type(4))) short;
using f32x16 = __attribute__((ext_vector_type(16))) float;
using u32x4  = __attribute__((ext_vector_type(4))) unsigned;
#define KSWZ(row, colB) ((row) * 256 + ((colB) ^ (((row) & 7) << 4)))
#define SBAR() __builtin_amdgcn_sched_barrier(0)
__device__ __forceinline__ int crow(int r, int hi) { return (r & 3) + 8 * (r >> 2) + 4 * hi; }
__device__ __forceinline__ unsigned cvtpk(float lo, float hi) { unsigned r; asm volatile("v_cvt_pk_bf16_f32 %0, %1, %2" : "=v"(r) : "v"(lo), "v"(hi)); return r; }

__device__ __forceinline__ void partialSM(f32x16& p0, f32x16& p1, float& m_reg, float& mn, float& alpha) {
  constexpr float C = SCALE * 1.4426950408889634f;
  float pmax = p0[0];
#pragma unroll
  for (int r = 1; r < 16; ++r) pmax = fmaxf(pmax, p0[r]);
#pragma unroll
  for (int r = 0; r < 16; ++r) pmax = fmaxf(pmax, p1[r]);
  { auto rr = __builtin_amdgcn_permlane32_swap(__float_as_uint(pmax), __float_as_uint(pmax), false, false);
    pmax = fmaxf(__uint_as_float(rr[0]), __uint_as_float(rr[1])); }
  if (__builtin_expect(__all(pmax - m_reg <= THR / SCALE), 1)) { mn = m_reg; alpha = 1.f; }
  else { mn = fmaxf(m_reg, pmax); alpha = __builtin_amdgcn_exp2f((m_reg - mn) * C); m_reg = mn; }
  float mnC = -mn * C;
#pragma unroll
  for (int r = 0; r < 16; ++r) p0[r] = fmaf(p0[r], C, mnC);
#pragma unroll
  for (int r = 0; r < 16; ++r) p1[r] = fmaf(p1[r], C, mnC);
#pragma unroll
  for (int r = 0; r < 16; ++r) p0[r] = __builtin_amdgcn_exp2f(p0[r]);
}
__device__ __forceinline__ void finishSM(f32x16& p0, f32x16& p1, float alpha, float& l_reg, bf16x8& pa0, bf16x8& pa1, bf16x8& pa2, bf16x8& pa3) {
#pragma unroll
  for (int r = 0; r < 16; ++r) p1[r] = __builtin_amdgcn_exp2f(p1[r]);
  float ps = 0;
#pragma unroll
  for (int r = 0; r < 16; ++r) ps += p0[r];
#pragma unroll
  for (int r = 0; r < 16; ++r) ps += p1[r];
  { auto rr = __builtin_amdgcn_permlane32_swap(__float_as_uint(ps), __float_as_uint(ps), false, false);
    ps = __uint_as_float(rr[0]) + __uint_as_float(rr[1]); }
  l_reg = l_reg * alpha + ps;
#define PK4(P, BASE, OUT) do { unsigned a0 = cvtpk(P[BASE + 0], P[BASE + 1]), a1 = cvtpk(P[BASE + 2], P[BASE + 3]);   \
    unsigned b0 = cvtpk(P[BASE + 4], P[BASE + 5]), b1 = cvtpk(P[BASE + 6], P[BASE + 7]);                              \
    auto r0 = __builtin_amdgcn_permlane32_swap(a0, b0, false, false); auto r1 = __builtin_amdgcn_permlane32_swap(a1, b1, false, false); \
    u32x4 w = {r0[0], r1[0], r0[1], r1[1]}; OUT = *reinterpret_cast<bf16x8*>(&w); } while (0)
  PK4(p0, 0, pa0); PK4(p0, 8, pa1); PK4(p1, 0, pa2); PK4(p1, 8, pa3);
#undef PK4
}
__device__ __forceinline__ void qkt(f32x16& p0, f32x16& p1, const bf16* Ks, const bf16x8* qr, int r32, int hi) {
  p0 = f32x16{}; p1 = f32x16{};
#pragma unroll
  for (int d0 = 0; d0 < 8; ++d0) { int cb = (d0 * 16 + hi * 8) * 2;
    bf16x8 b0 = *reinterpret_cast<const bf16x8*>((const char*)Ks + KSWZ(r32, cb));
    bf16x8 b1 = *reinterpret_cast<const bf16x8*>((const char*)Ks + KSWZ(32 + r32, cb));
    p0 = __builtin_amdgcn_mfma_f32_32x32x16_bf16(b0, qr[d0], p0, 0, 0, 0);
    p1 = __builtin_amdgcn_mfma_f32_32x32x16_bf16(b1, qr[d0], p1, 0, 0, 0); }
}
__device__ __forceinline__ int v_st(int k, int c) { const int kk = (k & ~0xC) | ((k & 4) << 1) | ((k & 8) >> 1); return ((kk >> 3) * 4 + (c >> 5)) * 512 + ((kk & 7) * 32 + (c & 31)) * 2; }
__device__ __forceinline__ int v_rd_base(int lane) { return ((lane & 3) << 3) | (((lane >> 2) & 3) << 6) | (((lane >> 4) & 1) << 5) | (((lane >> 5) & 1) << 8); }
constexpr int v_rd_off(int d0, int ks, int half) { return d0 * 512 + ks * 4096 + half * 2048; }
template <int OFF> __device__ __forceinline__ s16x4 tr_read(int vb) {
  s16x4 r; asm volatile("ds_read_b64_tr_b16 %0, %1 offset:%2" : "=&v"(r) : "v"(vb), "i"(OFF) : "memory"); return r;
}
template <int D0> __device__ __forceinline__ void pv_one(f32x16& od, int vb, bf16x8 pa0, bf16x8 pa1, bf16x8 pa2, bf16x8 pa3) {
  const s16x4 l0 = tr_read<v_rd_off(D0, 0, 0)>(vb), h0 = tr_read<v_rd_off(D0, 0, 1)>(vb), l1 = tr_read<v_rd_off(D0, 1, 0)>(vb), h1 = tr_read<v_rd_off(D0, 1, 1)>(vb);
  const s16x4 l2 = tr_read<v_rd_off(D0, 2, 0)>(vb), h2 = tr_read<v_rd_off(D0, 2, 1)>(vb), l3 = tr_read<v_rd_off(D0, 3, 0)>(vb), h3 = tr_read<v_rd_off(D0, 3, 1)>(vb);
  asm volatile("s_waitcnt lgkmcnt(0)" ::: "memory"); SBAR();
#define PK(L, H) (bf16x8){L[0], L[1], L[2], L[3], H[0], H[1], H[2], H[3]}
  od = __builtin_amdgcn_mfma_f32_32x32x16_bf16(pa0, PK(l0, h0), od, 0, 0, 0);
  od = __builtin_amdgcn_mfma_f32_32x32x16_bf16(pa1, PK(l1, h1), od, 0, 0, 0);
  od = __builtin_amdgcn_mfma_f32_32x32x16_bf16(pa2, PK(l2, h2), od, 0, 0, 0);
  od = __builtin_amdgcn_mfma_f32_32x32x16_bf16(pa3, PK(l3, h3), od, 0, 0, 0);
#undef PK
}
__device__ __forceinline__ void pv_d0(f32x16* o, int vb, bf16x8 pa0, bf16x8 pa1, bf16x8 pa2, bf16x8 pa3) {
  pv_one<0>(o[0], vb, pa0, pa1, pa2, pa3); pv_one<1>(o[1], vb, pa0, pa1, pa2, pa3); pv_one<2>(o[2], vb, pa0, pa1, pa2, pa3); pv_one<3>(o[3], vb, pa0, pa1, pa2, pa3);
}

template <int MODE, bool QPREP = false>
__device__ __forceinline__ void attn_unit(const bf16* __restrict__ Qb, long ldq, const bf16* __restrict__ Kh, const bf16* __restrict__ Vh, long ldk,
                                          bf16* Ob, long ldo, int NT, char* lds, int kpos0, int npos, const float* tab, float* lse_out, long lse_stride, const float* qgain = nullptr, int qs0 = 0) {
  int tid = threadIdx.x; asm volatile("" : "+v"(tid));
  const int wid = __builtin_amdgcn_readfirstlane(tid >> 6), lane = tid & 63, r32 = lane & 31, hi = lane >> 5;
  constexpr int KOFF = (MODE == 0) ? 0 : (int)(2 * SHM_V), VOFF = (MODE == 0) ? 65536 : 0, WSOFF = (MODE == 0) ? (131072 + 1024) : (int)(2 * SHM_V + 2 * SHM_K);
  bf16* V_lds = (bf16*)(lds + VOFF); bf16* K_lds = (bf16*)(lds + KOFF);
  float* ws = (float*)(lds + WSOFF) + wid * 64; float* li_l = ws; float* al_l = ws + 32;
  float m_reg = -1e30f, l_reg = 0; f32x16 o[4] = {}; bf16x8 qr[8];
  const bf16* Qw = Qb + (long)(wid * QBLK + r32) * ldq + hi * 8;
#pragma unroll
  for (int d0 = 0; d0 < 8; ++d0) qr[d0] = *reinterpret_cast<const bf16x8*>(Qw + d0 * 16);
  if constexpr (QPREP) {
    float x[8][8]; float ssq = 0.f;
#pragma unroll
    for (int d0 = 0; d0 < 8; ++d0)
#pragma unroll
      for (int j = 0; j < 8; ++j) { x[d0][j] = __builtin_bit_cast(float, (unsigned)(unsigned short)qr[d0][j] << 16); ssq += x[d0][j] * x[d0][j]; }
    { auto rr = __builtin_amdgcn_permlane32_swap(__float_as_uint(ssq), __float_as_uint(ssq), false, false); ssq = __uint_as_float(rr[0]) + __uint_as_float(rr[1]); }
    const float rstd = 1.0f / sqrtf(ssq * (1.0f / 128.0f) + 1e-6f);
    const int sq = qs0 + wid * QBLK + r32;
#pragma unroll
    for (int aa = 0; aa < 2; ++aa) { const float pos = (float)(aa == 0 ? (sq >> 6) : (sq & 63));
#pragma unroll
      for (int dd = 0; dd < 2; ++dd) { const int d0 = aa * 4 + dd;
#pragma unroll
        for (int j = 0; j < 8; ++j) { const int i = 16 * dd + 8 * hi + j; const int e1 = aa * 64 + i;
          const float rev = pos * exp2f(-(float)i * 0.41524101186092029f) * 0.15915494309189535f;
          const float sn = __builtin_amdgcn_sinf(rev), cs = __builtin_amdgcn_cosf(rev);
          const float y1 = x[d0][j] * rstd * qgain[e1], y2 = x[d0 + 2][j] * rstd * qgain[e1 + 32];
          x[d0][j] = y1 * cs - y2 * sn; x[d0 + 2][j] = y2 * cs + y1 * sn; } } }
#pragma unroll
    for (int d0 = 0; d0 < 8; ++d0) { u32x4 w = {cvtpk(x[d0][0], x[d0][1]), cvtpk(x[d0][2], x[d0][3]), cvtpk(x[d0][4], x[d0][5]), cvtpk(x[d0][6], x[d0][7])}; qr[d0] = *reinterpret_cast<bf16x8*>(&w); }
  }
  const int sr = tid >> 4, sc = (tid & 15) * 8, vst0 = v_st(sr, sc), vst1 = vst0 + 8192;
  const int vb0 = (int)(uintptr_t)V_lds + v_rd_base(lane);
  const int qrel = wid * QBLK + r32;
  constexpr int SD = (MODE == 0) ? ATT_SD0 : 2;
  struct { bf16x8 vs0, vs1, ks0, ks1; } sr_[SD];
  const unsigned soff0 = (unsigned)(sr * (int)ldk + sc) * 2u, soff1 = soff0 + (unsigned)(32 * (int)ldk) * 2u;
#define KPOS(j) ((MODE == 1) ? ((kpos0 + (j) * KVBLK >= 0 && kpos0 + (j) * KVBLK < npos) ? (kpos0 + (j) * KVBLK) : 0) : ((j) * KVBLK))
#define SLOAD(i, j) do { const size_t kb_ = (size_t)KPOS(j) * (size_t)ldk * 2; const char* Kt_ = (const char*)Kh + kb_; const char* Vt_ = (const char*)Vh + kb_; \
    sr_[i].vs0 = *reinterpret_cast<const bf16x8*>(Vt_ + soff0); sr_[i].vs1 = *reinterpret_cast<const bf16x8*>(Vt_ + soff1); \
    sr_[i].ks0 = *reinterpret_cast<const bf16x8*>(Kt_ + soff0); sr_[i].ks1 = *reinterpret_cast<const bf16x8*>(Kt_ + soff1); } while (0)
#define SWRITE(b, i) do { *(bf16x8*)((char*)V_lds + (b) * SHM_V + vst0) = sr_[i].vs0;          \
    *(bf16x8*)((char*)V_lds + (b) * SHM_V + vst1) = sr_[i].vs1; int kc = sc * 2;               \
    *(bf16x8*)((char*)K_lds + (b) * SHM_K + KSWZ(sr, kc)) = sr_[i].ks0;                       \
    *(bf16x8*)((char*)K_lds + (b) * SHM_K + KSWZ(32 + sr, kc)) = sr_[i].ks1; } while (0)
#define SWAIT() do { if constexpr (SD == 2) asm volatile("s_waitcnt vmcnt(4)" ::: "memory"); else asm volatile("s_waitcnt vmcnt(0)" ::: "memory"); } while (0)
#define RESC(a) do { if (__any((a) < 1.f)) { if (hi == 0) al_l[r32] = (a); asm volatile("s_waitcnt lgkmcnt(0)" ::: "memory"); \
    _Pragma("unroll") for (int d = 0; d < 4; ++d) _Pragma("unroll") for (int r = 0; r < 16; ++r) o[d][r] *= al_l[crow(r, hi)]; } } while (0)
#define BIASM(P0, P1, j) do { if constexpr (MODE == 1) { const int kp_ = kpos0 + (j) * KVBLK; \
    if (kp_ >= 0 && kp_ < npos) { const float* tb_ = tab + ((j) * KVBLK - 64 + 4 * hi - qrel + TAB_PAD); \
      _Pragma("unroll") for (int r = 0; r < 16; ++r) { P0[r] += tb_[(r & 3) + 8 * (r >> 2)]; P1[r] += tb_[32 + (r & 3) + 8 * (r >> 2)]; } } \
    else { _Pragma("unroll") for (int r = 0; r < 16; ++r) { P0[r] = -INFINITY; P1[r] = -INFINITY; } } } } while (0)
  if constexpr (MODE == 1) {
    f32x16 pA0, pA1; float mnA, alA; bf16x8 pa0, pa1, pa2, pa3;
    const int jlo = wid >> 1;
    SLOAD(0, 0); SLOAD(1, 1);
    for (int j = 0; j < NT; j += 2) {
      SWRITE(0, 0); __syncthreads();
      if (j + 2 < NT) SLOAD(0, j + 2);
      if (j >= jlo && j <= jlo + 2) {
        qkt(pA0, pA1, K_lds, qr, r32, hi); BIASM(pA0, pA1, j); partialSM(pA0, pA1, m_reg, mnA, alA);
        RESC(alA);
        finishSM(pA0, pA1, alA, l_reg, pa0, pa1, pa2, pa3); SBAR();
        pv_d0(o, vb0, pa0, pa1, pa2, pa3);
      }
      SWRITE(1, 1); __syncthreads();
      if (j + 3 < NT) SLOAD(1, j + 3);
      if (j + 1 >= jlo && j + 1 <= jlo + 2) {
        qkt(pA0, pA1, (bf16*)((char*)K_lds + SHM_K), qr, r32, hi); BIASM(pA0, pA1, j + 1); partialSM(pA0, pA1, m_reg, mnA, alA);
        RESC(alA);
        finishSM(pA0, pA1, alA, l_reg, pa0, pa1, pa2, pa3); SBAR();
        pv_d0(o, vb0 + (int)SHM_V, pa0, pa1, pa2, pa3);
      }
    }
  } else {
  f32x16 pA0, pA1, pB0, pB1; float mnA, mnB, alA, alB; bf16x8 pa0, pa1, pa2, pa3;
  bf16x8 pv0_, pv1_, pv2_, pv3_, pk0_, pk1_, pk2_, pk3_;
  const int NP = NT >> 1;
  const unsigned rstep = (unsigned)(32 * (int)ldk) * 2u;
#define PLOADK(pp) do { const size_t kb_ = (size_t)(pp) * 128 * (size_t)ldk * 2; const char* Kt_ = (const char*)Kh + kb_ + soff0; \
    pk0_ = *reinterpret_cast<const bf16x8*>(Kt_); pk1_ = *reinterpret_cast<const bf16x8*>(Kt_ + rstep); pk2_ = *reinterpret_cast<const bf16x8*>(Kt_ + 2 * rstep); pk3_ = *reinterpret_cast<const bf16x8*>(Kt_ + 3 * rstep); } while (0)
#define PLOADV(pp) do { const size_t kb_ = (size_t)(pp) * 128 * (size_t)ldk * 2; const char* Vt_ = (const char*)Vh + kb_ + soff0; \
    pv0_ = *reinterpret_cast<const bf16x8*>(Vt_); pv1_ = *reinterpret_cast<const bf16x8*>(Vt_ + rstep); pv2_ = *reinterpret_cast<const bf16x8*>(Vt_ + 2 * rstep); pv3_ = *reinterpret_cast<const bf16x8*>(Vt_ + 3 * rstep); } while (0)
#define PLOAD(pp) do { PLOADK(pp); PLOADV(pp); } while (0)
#define PWRITE(c) do { const int kc = sc * 2; char* vb_ = (char*)V_lds + (c) * 32768; char* kb2_ = (char*)K_lds + (c) * 32768; \
    *(bf16x8*)(vb_ + vst0) = pv0_; *(bf16x8*)(vb_ + vst1) = pv1_; *(bf16x8*)(vb_ + 16384 + vst0) = pv2_; *(bf16x8*)(vb_ + 16384 + vst1) = pv3_; \
    *(bf16x8*)(kb2_ + KSWZ(sr, kc)) = pk0_; *(bf16x8*)(kb2_ + KSWZ(32 + sr, kc)) = pk1_; *(bf16x8*)(kb2_ + 16384 + KSWZ(sr, kc)) = pk2_; *(bf16x8*)(kb2_ + 16384 + KSWZ(32 + sr, kc)) = pk3_; } while (0)
#define KSUB(c, sb) ((bf16*)((char*)K_lds + (c) * 32768 + (sb) * 16384))
#define VSUB(c, sb) (vb0 + (c) * 32768 + (sb) * 16384)
  PLOAD(0); asm volatile("s_waitcnt vmcnt(0)" ::: "memory"); PWRITE(0); __syncthreads();
  qkt(pA0, pA1, KSUB(0, 0), qr, r32, hi); partialSM(pA0, pA1, m_reg, mnA, alA);
#define PAIR_FULL(c, oc, NEXTP) do { \
    SBAR(); PLOADK(NEXTP); qkt(pB0, pB1, KSUB(c, 1), qr, r32, hi); \
    finishSM(pA0, pA1, alA, l_reg, pa0, pa1, pa2, pa3); SBAR(); \
    PLOADV(NEXTP); \
    pv_d0(o, VSUB(c, 0), pa0, pa1, pa2, pa3); partialSM(pB0, pB1, m_reg, mnB, alB); \
    RESC(alB); \
    PWRITE(oc); \
    __syncthreads(); \
    SBAR(); qkt(pA0, pA1, KSUB(oc, 0), qr, r32, hi); \
    finishSM(pB0, pB1, alB, l_reg, pa0, pa1, pa2, pa3); SBAR(); \
    pv_d0(o, VSUB(c, 1), pa0, pa1, pa2, pa3); partialSM(pA0, pA1, m_reg, mnA, alA); \
    RESC(alA); \
    __syncthreads(); } while (0)
  for (int p = 0; p + 2 < NP; p += 2) {
    PAIR_FULL(0, 1, p + 1);
    PAIR_FULL(1, 0, p + 2);
  }
  PAIR_FULL(0, 1, NP - 1);
  { SBAR(); qkt(pB0, pB1, KSUB(1, 1), qr, r32, hi);
    finishSM(pA0, pA1, alA, l_reg, pa0, pa1, pa2, pa3); SBAR();
    pv_d0(o, VSUB(1, 0), pa0, pa1, pa2, pa3); partialSM(pB0, pB1, m_reg, mnB, alB);
    RESC(alB);
    finishSM(pB0, pB1, alB, l_reg, pa0, pa1, pa2, pa3); SBAR();
    pv_d0(o, VSUB(1, 1), pa0, pa1, pa2, pa3); }
#undef PAIR_FULL
#undef PLOAD
#undef PLOADK
#undef PLOADV
#undef PWRITE
#undef KSUB
#undef VSUB
  }
  if (hi == 0) li_l[r32] = l_reg; asm volatile("s_waitcnt lgkmcnt(0)" ::: "memory");
  if constexpr (MODE == 1) { if (hi == 0) lse_out[(long)(wid * QBLK + r32) * lse_stride] = m_reg * SCALE + __logf(l_reg); }
  float rli[16];
#pragma unroll
  for (int r = 0; r < 16; ++r) rli[r] = __builtin_amdgcn_rcpf(li_l[crow(r, hi)]);
  bf16* Ow = Ob + (long)(wid * QBLK) * ldo;
#pragma unroll
  for (int r = 0; r < 16; ++r) { const int orow = crow(r, hi);
#pragma unroll
    for (int d0 = 0; d0 < 4; ++d0) Ow[(long)orow * ldo + d0 * 32 + r32] = __float2bfloat16(o[d0][r] * rli[r]); }
  __syncthreads();
#undef KPOS
#undef SLOAD
#undef SWRITE
#undef SWAIT
#undef RESC
#undef BIASM
}
#undef SBAR
}

constexpr int NWAVES = 8;
constexpr int DM = 2048, BATCH = 2, SEQ = 16384, MTOK = BATCH * SEQ, DFF = 5632, INW = 10752, MEMT = 256, MEMW = 512;
constexpr int O_QA = 0, O_KA = 1024, O_VA = 1280, O_QB = 1536, O_KB = 4608, O_VB = 7680;
constexpr float EPS = 1e-6f;
constexpr size_t MiB = 1u << 20;
constexpr size_t WS_WGU1 = 1 * MiB, WS_WD1 = WS_WGU1 + 44 * MiB, WS_WGU2 = WS_WD1 + 22 * MiB, WS_WD2 = WS_WGU2 + 44 * MiB, WS_WIN = WS_WD2 + 22 * MiB,
                 WS_WOUT = WS_WIN + 42 * MiB, WS_WQM = WS_WOUT + 8 * MiB, WS_WKVM = WS_WQM + 2 * MiB, WS_WOM = WS_WKVM + 4 * MiB, WS_HM = WS_WOM + 2 * MiB,
                 WS_KVM = WS_HM + 2 * MiB, WS_LSE = WS_KVM + 1 * MiB, WS_H = 200 * MiB, WS_PROJ = 328 * MiB, WS_END = 1000 * MiB;
static_assert(WS_LSE + 3 * MiB <= WS_H, "ws map");
constexpr size_t WS_ACT = WS_PROJ, WS_QM = WS_PROJ, WS_OM = WS_PROJ + 32 * MiB;
constexpr int RING_BYTES = 131072, LDS_BYTES = 131072 + 1024 + 2048;
constexpr int NPH = 17;

typedef unsigned short bf16r;
typedef float f32x4 __attribute__((ext_vector_type(4)));
typedef unsigned v4u __attribute__((ext_vector_type(4)));
#define LAS __attribute__((address_space(3)))

__device__ __forceinline__ unsigned f2bf(float f) { unsigned u = __builtin_bit_cast(unsigned, f); return (u + 0x7fffu + ((u >> 16) & 1u)) >> 16; }
__device__ __forceinline__ unsigned pk2(float lo, float hi) { return f2bf(lo) | (f2bf(hi) << 16); }
__device__ __forceinline__ float bf2f(unsigned short b) { return __builtin_bit_cast(float, (unsigned)b << 16); }
__device__ __forceinline__ float wave_sum(float v) {
#pragma unroll
    for (int o = 1; o < 64; o <<= 1) v += __shfl_xor(v, o);
    return v;
}
__device__ __forceinline__ void transpose_item(const float* W, int K, int N, bf16r* WT, int k0, int n0, int drow0, LAS float* scr, int lane, const float* gain) {
    { const int kr = lane >> 3, nq = lane & 7; f32x4 v[8];
#pragma unroll
      for (int i = 0; i < 8; ++i) v[i] = *(const f32x4*)(W + (size_t)(k0 + 8 * i + kr) * N + n0 + 4 * nq);
      if (gain) {
#pragma unroll
        for (int i = 0; i < 8; ++i) v[i] = v[i] * gain[k0 + 8 * i + kr]; }
#pragma unroll
      for (int i = 0; i < 8; ++i) { LAS float* d = scr + (8 * i + kr) * 33 + 4 * nq; d[0] = v[i].x; d[1] = v[i].y; d[2] = v[i].z; d[3] = v[i].w; } }
    asm volatile("s_waitcnt lgkmcnt(0)" ::: "memory");
    const int c = lane & 7;
#pragma unroll
    for (int j = 0; j < 4; ++j) { const int n = (lane >> 3) + 8 * j; const LAS float* s = scr + (8 * c) * 33 + n;
        v4u o; o.x = pk2(s[0 * 33], s[1 * 33]); o.y = pk2(s[2 * 33], s[3 * 33]); o.z = pk2(s[4 * 33], s[5 * 33]); o.w = pk2(s[6 * 33], s[7 * 33]);
        *(v4u*)(WT + (size_t)(drow0 + n) * K + k0 + 8 * c) = o; }
    asm volatile("s_waitcnt lgkmcnt(0)" ::: "memory");
}
__device__ __forceinline__ void transpose_mat(const float* W, int K, int N, bf16r* WT, int mode, int item, LAS float* scr, int lane, const float* gain = nullptr) {
    const int nblk = N / 32, kb = item / nblk, nb = item % nblk, k0 = 64 * kb, n0 = 32 * nb;
    int drow0 = n0;
    if (mode != 0) drow0 = (n0 >> 7) * 256 + (n0 & 127) + (mode == 2 ? 128 : 0);
    transpose_item(W, K, N, WT, k0, n0, drow0, scr, lane, gain);
}
__device__ __forceinline__ void rms_row_bf16(const float* xrow, const float* g, bf16r* orow, int lane) {
    const f32x4* xr = (const f32x4*)xrow + lane; f32x4 v[8]; float s = 0.f;
#pragma unroll
    for (int j = 0; j < 8; ++j) { v[j] = xr[64 * j]; s += (v[j].x * v[j].x + v[j].y * v[j].y) + (v[j].z * v[j].z + v[j].w * v[j].w); }
    const float rstd = 1.0f / sqrtf(wave_sum(s) * (1.f / DM) + EPS);
    const f32x4* gr = (const f32x4*)g + lane; unsigned long long* o8 = (unsigned long long*)orow + lane;
#pragma unroll
    for (int j = 0; j < 8; ++j) { const f32x4 gv = gr[64 * j]; const f32x4 y = v[j] * rstd * gv;
        o8[64 * j] = (unsigned long long)pk2(y.x, y.y) | ((unsigned long long)pk2(y.z, y.w) << 32); }
}
__device__ __forceinline__ void rms_row_f32(float* xrow, const float* g, int lane) {
    f32x4* xr = (f32x4*)xrow + lane; f32x4 v[8]; float s = 0.f;
#pragma unroll
    for (int j = 0; j < 8; ++j) { v[j] = xr[64 * j]; s += (v[j].x * v[j].x + v[j].y * v[j].y) + (v[j].z * v[j].z + v[j].w * v[j].w); }
    const float rstd = 1.0f / sqrtf(wave_sum(s) * (1.f / DM) + EPS);
    const f32x4* gr = (const f32x4*)g + lane;
#pragma unroll
    for (int j = 0; j < 8; ++j) { const f32x4 gv = gr[64 * j]; xr[64 * j] = v[j] * rstd * gv; }
}
__device__ __forceinline__ int t5_bucket(int rel) {
    const int n = rel < 0 ? -rel : rel; int v;
    if (n < 8) v = n; else v = 8 + (n >= 15) + (n >= 27) + (n >= 50) + (n >= 91) + (n >= 166) + (n >= 305) + (n >= 559);
    return (rel > 0 ? 16 : 0) + v;
}


#define RLX_AGENT __ATOMIC_RELAXED, __HIP_MEMORY_SCOPE_AGENT
#define XB_TMO      128
#define XB_XCNT(j)  (256  + 64 * (j))
#define XB_XSUB(j)  (1280 + 64 * (j))
#define XB_XGEN(j)  (2304 + 64 * (j))
#define XB_TOP      3328
#define XB_TOPGEN   3392
#define XCD_BAR_WORDS 3456
#define XB_SPIN_CAP (1u << 22)

__device__ __forceinline__ unsigned xb_ld(unsigned* p)              { return __hip_atomic_load(p, __ATOMIC_RELAXED, __HIP_MEMORY_SCOPE_AGENT); }
__device__ __forceinline__ unsigned xb_add(unsigned* p, unsigned v) { return __hip_atomic_fetch_add(p, v, __ATOMIC_RELAXED, __HIP_MEMORY_SCOPE_AGENT); }
__device__ __forceinline__ unsigned xb_xcc_id() { return (unsigned)__builtin_amdgcn_s_getreg((3 << 11) | 20) & 0xFu; }
#define XB_SPIN(cond, bar) do { unsigned _sp = 0; while (cond) { __builtin_amdgcn_s_sleep(1); \
    if ((++_sp & 255u) == 0u) { if (xb_ld(&(bar)[XB_TMO])) break; if (_sp > XB_SPIN_CAP) { atomicAdd(&(bar)[XB_TMO], 1u); break; } } } } while (0)

struct XcdBarrier {
    unsigned* bar; unsigned x;
    volatile LAS unsigned* st;
};

__device__ __forceinline__ XcdBarrier xcd_barrier_post(unsigned* bar, volatile LAS unsigned* st) {
    XcdBarrier b; b.bar = bar; b.x = xb_xcc_id(); b.st = st;
    if (threadIdx.x == 0) (void)xb_add(&bar[XB_XCNT(b.x)], 1u);
    return b;
}
__device__ __forceinline__ void xcd_barrier_complete(unsigned* bar, unsigned x, unsigned& nloc, unsigned& nx) {
    const unsigned G = gridDim.x * gridDim.y * gridDim.z;
    unsigned sum, cnt, mine, sp = 0u;
    for (;;) {
        sum = 0u; cnt = 0u; mine = 0u;
#pragma unroll
        for (unsigned j = 0; j < 16; ++j) { const unsigned c = xb_ld(&bar[XB_XCNT(j)]); sum += c; cnt += (c > 0u) ? 1u : 0u; mine = (j == x) ? c : mine; }
        if (sum == G) break;
        __builtin_amdgcn_s_sleep(1);
        if ((++sp & 255u) == 0u) { if (xb_ld(&bar[XB_TMO])) break; if (sp > XB_SPIN_CAP) { atomicAdd(&bar[XB_TMO], 1u); break; } }
    }
    nloc = mine > 0u ? mine : 1u; nx = cnt > 0u ? cnt : 1u;
}

__device__ __forceinline__ void xcd_barrier(const XcdBarrier& b) {
    asm volatile("s_waitcnt vmcnt(0)" ::: "memory");
    __syncthreads();
    if (threadIdx.x == 0) {
        unsigned* bar = b.bar;
        __builtin_amdgcn_s_waitcnt(0);
        unsigned nloc = b.st[0], nx = b.st[1];
        if (nloc == 0u) { xcd_barrier_complete(bar, b.x, nloc, nx); b.st[0] = nloc; b.st[1] = nx; }
        const unsigned old = xb_add(&bar[XB_XSUB(b.x)], 1u);
        const unsigned gen = old / nloc;
        if (old + 1u == (gen + 1u) * nloc) {
            __builtin_amdgcn_fence(__ATOMIC_RELEASE, "agent");
            asm volatile("s_waitcnt vmcnt(0)" ::: "memory");
            const unsigned og = xb_add(&bar[XB_TOP], 1u);
            const unsigned tg = og / nx;
            if (og + 1u == (tg + 1u) * nx) xb_add(&bar[XB_TOPGEN], 1u);
            else XB_SPIN(xb_ld(&bar[XB_TOPGEN]) == tg, bar);
            __builtin_amdgcn_fence(__ATOMIC_ACQUIRE, "agent");
            xb_add(&bar[XB_XGEN(b.x)], 1u);
            asm volatile("s_waitcnt vmcnt(0)" ::: "memory");
        } else {
            XB_SPIN(xb_ld(&bar[XB_XGEN(b.x)]) == gen, bar);
            __builtin_amdgcn_fence(__ATOMIC_ACQUIRE, "agent");
            asm volatile("s_waitcnt vmcnt(0)" ::: "memory");
        }
    }
    __syncthreads();
}

struct Args { const float* in[22]; float* out; unsigned char* ws; int ph_lo, ph_hi; };
enum { I_X = 0, I_MEM, I_F1N, I_F1G, I_F1U, I_F1D, I_MIXN, I_WIN, I_QN, I_KN, I_RELB, I_WOUT, I_MXN, I_MMN, I_WQM, I_WKVM, I_WOM, I_F2N, I_F2G, I_F2U, I_F2D, I_FIN };

__global__ void __launch_bounds__(NWAVES * 64, 2) mk_fwd(Args args) {
    extern __shared__ __attribute__((aligned(16))) unsigned char lds[];
    LAS unsigned char* ldsl = (LAS unsigned char*)lds;
    const int tid = threadIdx.x, lane = tid & 63, wave = __builtin_amdgcn_readfirstlane(tid >> 6);
    const int G = gridDim.x, bx = blockIdx.x;
    const int vcu = (G % 8 == 0) ? (bx % 8) * (G / 8) + bx / 8 : bx;
    const int gw = vcu * NWAVES + wave, NGW = G * NWAVES;
    unsigned char* ws = args.ws;
    float* out = args.out;
#define WGU1 ((bf16r*)(ws + WS_WGU1))
#define WD1 ((bf16r*)(ws + WS_WD1))
#define WGU2 ((bf16r*)(ws + WS_WGU2))
#define WD2 ((bf16r*)(ws + WS_WD2))
#define WIN ((bf16r*)(ws + WS_WIN))
#define WOUT ((bf16r*)(ws + WS_WOUT))
#define WQM ((bf16r*)(ws + WS_WQM))
#define WKVM ((bf16r*)(ws + WS_WKVM))
#define WOM ((bf16r*)(ws + WS_WOM))
#define HM ((bf16r*)(ws + WS_HM))
#define KVM ((bf16r*)(ws + WS_KVM))
#define LSE ((float*)(ws + WS_LSE))
#define H ((bf16r*)(ws + WS_H))
#define PROJ ((bf16r*)(ws + WS_PROJ))
#define ACT ((bf16r*)(ws + WS_ACT))
#define QM ((bf16r*)(ws + WS_QM))
#define OM ((bf16r*)(ws + WS_OM))
#define MIX ((bf16r*)out)
#define PCNT ((unsigned*)(ws + 32768))
#define SS ((float*)(ws + 65536))
#define XB2 ((bf16r*)(ws + WS_PROJ + 64 * MiB))
    const int lo = args.ph_lo, hi = args.ph_hi;
#ifndef PH_MASK
#define PH_MASK 0x1ffff
#endif
#define IN(k) (((PH_MASK >> (k)) & 1) && lo <= (k) && (k) < hi)
    volatile LAS unsigned* MISC = (volatile LAS unsigned*)(ldsl + RING_BYTES);
    if (tid < 16) MISC[tid] = 0u;
    __syncthreads();
    unsigned* barw = (unsigned*)ws;
    XcdBarrier xb; xb.bar = barw; xb.x = 0; xb.st = MISC;
#define SEAM(k) do { if (IN(k) && IN((k) + 1) && MK_N_LAUNCHES == 1) { if ((k) == 0) { cg::this_grid().sync(); xb = xcd_barrier_post(barw, MISC); } else { xcd_barrier(xb); } } } while (0)

    if (IN(0)) {
        if (bx == 0) { for (int t = tid; t < XCD_BAR_WORDS; t += NWAVES * 64) barw[t] = 0u; }
        LAS float* scr = (LAS float*)(ldsl + wave * 16384);
        constexpr int I_FG = (DM / 64) * (DFF / 32), I_FD = (DFF / 64) * (DM / 32), I_IN = (DM / 64) * (INW / 32), I_OUT = (DM / 64) * (DM / 32),
                      I_QM = (DM / 64) * (MEMW / 32), I_KVM = (DM / 64) * (2 * MEMW / 32), I_OM = (MEMW / 64) * (DM / 32);
        constexpr int NITEMS = 4 * I_FG + 2 * I_FD + I_IN + I_OUT + I_QM + I_KVM + I_OM;
        for (int it = gw; it < NITEMS; it += NGW) {
            int r = it;
            if (r < I_FG) { transpose_mat(args.in[I_F1G], DM, DFF, WGU1, 1, r, scr, lane); continue; } r -= I_FG;
            if (r < I_FG) { transpose_mat(args.in[I_F1U], DM, DFF, WGU1, 2, r, scr, lane); continue; } r -= I_FG;
            if (r < I_FD) { transpose_mat(args.in[I_F1D], DFF, DM, WD1, 0, r, scr, lane); continue; } r -= I_FD;
            if (r < I_IN) { transpose_mat(args.in[I_WIN], DM, INW, WIN, 0, r, scr, lane, args.in[I_MIXN]); continue; } r -= I_IN;
            if (r < I_OUT) { transpose_mat(args.in[I_WOUT], DM, DM, WOUT, 0, r, scr, lane); continue; } r -= I_OUT;
            if (r < I_QM) { transpose_mat(args.in[I_WQM], DM, MEMW, WQM, 0, r, scr, lane, args.in[I_MXN]); continue; } r -= I_QM;
            if (r < I_KVM) { transpose_mat(args.in[I_WKVM], DM, 2 * MEMW, WKVM, 0, r, scr, lane); continue; } r -= I_KVM;
            if (r < I_OM) { transpose_mat(args.in[I_WOM], MEMW, DM, WOM, 0, r, scr, lane); continue; } r -= I_OM;
            if (r < I_FG) { transpose_mat(args.in[I_F2G], DM, DFF, WGU2, 1, r, scr, lane, args.in[I_F2N]); continue; } r -= I_FG;
            if (r < I_FG) { transpose_mat(args.in[I_F2U], DM, DFF, WGU2, 2, r, scr, lane, args.in[I_F2N]); continue; } r -= I_FG;
            transpose_mat(args.in[I_F2D], DFF, DM, WD2, 0, r, scr, lane);
        }
        for (int i = gw * 64 + lane; i < 4 * MTOK; i += NGW * 64) SS[i] = 0.f;
        for (int i = gw * 64 + lane; i < 128 * 64; i += NGW * 64) PCNT[i] = 0u;
        for (int m = gw; m < MTOK; m += NGW) rms_row_bf16(args.in[I_X] + (size_t)m * DM, args.in[I_F1N], H + (size_t)m * DM, lane);
        for (int m = gw; m < BATCH * MEMT; m += NGW) rms_row_bf16(args.in[I_MEM] + (size_t)m * DM, args.in[I_MMN], HM + (size_t)m * DM, lane);
        __syncthreads();
    }
    SEAM(0);
    if (IN(1)) {
        { pg8::Gemm g{H, WGU1, MTOK, 2 * DFF, DM}; pg8::StaticOrder S; S.init(MTOK, 2 * DFF, G, bx, 4);
          pg8::EpiSwiGLU<false> E{ACT, DFF, nullptr};
          pg8::gemm_phase<pg8::EpiSwiGLU<false>, pg8::StaticOrder, true, true>(ldsl, g, S, E); }
        { pg8::Gemm g{HM, WKVM, BATCH * MEMT, 2 * MEMW, DM}; pg8::StaticOrder S; S.init(BATCH * MEMT, 2 * MEMW, G, bx);
          pg8::EpiBf16<false> E{KVM, 2 * MEMW, nullptr};
          pg8::gemm_phase<pg8::EpiBf16<false>, pg8::StaticOrder, true, true>(ldsl, g, S, E); }
    }
    SEAM(1);
    if (IN(2)) {
        pg8::Gemm g{ACT, WD1, MTOK, DM, DFF}; pg8::StaticOrder S; S.init(MTOK, DM, G, bx, 4);
        pg8::EpiRes<false, false, true> E{args.in[I_X], nullptr, nullptr, H, SS, DM, 0.5f};
        pg8::gemm_phase<pg8::EpiRes<false, false, true>, pg8::StaticOrder, true, true>(ldsl, g, S, E);
    }
    SEAM(2);
    if (IN(4)) {
        pg8::Gemm g{H, WIN, MTOK, INW, DM}; pg8::StaticOrder S; S.init(MTOK, INW, G, bx, 4);
        pg8::EpiBf16<true> E{PROJ, INW, SS};
        pg8::gemm_phase<pg8::EpiBf16<true>, pg8::StaticOrder, true, true>(ldsl, g, S, E);
    }
    SEAM(4);
    if (IN(5)) {
        const int hh = lane >> 5, a = (lane >> 4) & 1, i = (lane & 15) * 2;
        const float invf0 = exp2f(-(float)i * 0.41524101186092029f), invf1 = exp2f(-(float)(i + 1) * 0.41524101186092029f);
        const float* qn = args.in[I_QN] + a * 64 + i; const float* kn = args.in[I_KN] + a * 64 + i;
        const float gq1a = qn[0], gq1b = qn[1], gq2a = qn[32], gq2b = qn[33], gk1a = kn[0], gk1b = kn[1], gk2a = kn[32], gk2b = kn[33];
        for (int row = gw; row < MTOK; row += NGW) {
            const int s = row & (SEQ - 1);
            const float pos = (float)(a == 0 ? (s >> 6) : (s & 63));
            const float rev0 = pos * invf0 * 0.15915494309189535f, rev1 = pos * invf1 * 0.15915494309189535f;
            const float sn0 = __builtin_amdgcn_sinf(rev0), cs0 = __builtin_amdgcn_cosf(rev0), sn1 = __builtin_amdgcn_sinf(rev1), cs1 = __builtin_amdgcn_cosf(rev1);
            unsigned* prow = (unsigned*)(PROJ + (size_t)row * INW + a * 64 + i);
#pragma unroll
            for (int it = 4; it < 5; ++it) {
                unsigned* p = prow + (it * 2 + hh) * 64;
                const unsigned u1 = p[0], u2 = p[16];
                const float x1a = __builtin_bit_cast(float, u1 << 16), x1b = __builtin_bit_cast(float, u1 & 0xffff0000u);
                const float x2a = __builtin_bit_cast(float, u2 << 16), x2b = __builtin_bit_cast(float, u2 & 0xffff0000u);
                float ss = (x1a * x1a + x1b * x1b) + (x2a * x2a + x2b * x2b);
#pragma unroll
                for (int o = 1; o < 32; o <<= 1) ss += __shfl_xor(ss, o);
                const float rstd = 1.0f / sqrtf(ss * (1.f / 128.f) + EPS);
                const bool isq = it < 4;
                const float y1a = x1a * rstd * (isq ? gq1a : gk1a), y1b = x1b * rstd * (isq ? gq1b : gk1b);
                const float y2a = x2a * rstd * (isq ? gq2a : gk2a), y2b = x2b * rstd * (isq ? gq2b : gk2b);
                p[0] = pk2(y1a * cs0 - y2a * sn0, y1b * cs1 - y2b * sn1);
                p[16] = pk2(y2a * cs0 + y1a * sn0, y2b * cs1 + y1b * sn1);
            }
        }
    }
    SEAM(5);
    if (IN(6)) {
        const att::bf16* P = (const att::bf16*)PROJ;
        int u0, ustep, uend;
        if (G % 8 == 0) { const int per = G / 8, x = vcu / per, j = vcu % per; u0 = x * 128 + j; ustep = per; uend = x * 128 + 128; }
        else { u0 = bx; ustep = G; uend = 1024; }
        float* tab = (float*)((char*)lds + att::SHM_ATTN);
        const int bper = (3072 + G - 1) / G; int gh_prev = -1;
        const int bu0 = vcu * bper, bu1 = (bu0 + bper < 3072) ? bu0 + bper : 3072;
        const int nA = (uend > u0) ? (uend - u0 + ustep - 1) / ustep : 0;
        const int bchunk = (nA > 0) ? (bper + nA - 1) / nA : bper;
        const int nBc = (bu1 > bu0) ? (bu1 - bu0 + bchunk - 1) / bchunk : 0;
        const int nsteps = 2 * (nA > nBc ? nA : nBc), par = vcu & 1;
        for (int step = 0; step < nsteps; ++step) {
            const int k = step >> 1;
            if (((step + par) & 1) == 0) {
                const int u = u0 + k * ustep;
                if (k < nA && u < uend) {
                    const int combo = u >> 8, b = combo >> 1, kvh = combo & 1, hq = kvh * 4 + ((u >> 6) & 3), qb = u & 63;
                    const size_t rowq = (size_t)b * SEQ + (size_t)qb * 256;
                    att::attn_unit<0, true>(P + rowq * INW + O_QA + hq * 128, INW, P + (size_t)b * SEQ * INW + O_KA + kvh * 128, P + (size_t)b * SEQ * INW + O_VA + kvh * 128, INW,
                                      (att::bf16*)MIX + rowq * DM + hq * 128, DM, SEQ / 64, (char*)lds, 0, 0, nullptr, nullptr, 0, args.in[I_QN], qb * 256);
                    gh_prev = -1;
                }
            } else {
                for (int u = bu0 + k * bchunk; u < bu1 && u < bu0 + (k + 1) * bchunk; ++u) {
                    const int g = u >> 10, b = (u >> 9) & 1, h = (u >> 6) & 7, idx = u & 63;
                    const int r = (g == 0) ? 1 : (g == 1 ? 4 : 16), npos = SEQ / r, nblk = npos / 256, c = idx / nblk, qb = idx % nblk, a0 = qb * 256;
                    if ((g * 8 + h) != gh_prev) { gh_prev = g * 8 + h;
                    for (int t = tid; t < att::TAB_N; t += NWAVES * 64) { const int d = t - att::TAB_PAD;
                        tab[t] = (d >= -64 && d <= 64) ? args.in[I_RELB][t5_bucket(r * d) * 24 + g * 8 + h] * (1.0f / att::SCALE) : -INFINITY; } }
                    const size_t row0 = (size_t)b * SEQ + c;
                    const long ld = (long)r * INW;
                    att::bf16* Pq = (att::bf16*)PROJ + row0 * INW + O_QB + g * 1024 + h * 128;
                    const att::bf16* Pk = P + row0 * INW + O_KB + g * 1024 + h * 128;
                    const att::bf16* Pv = P + row0 * INW + O_VB + g * 1024 + h * 128;
                    float* lse = LSE + ((size_t)g * MTOK + row0 + (size_t)a0 * r) * 8 + h;
                    att::attn_unit<1>(Pq + (long)a0 * ld, ld, Pk, Pv, ld, Pq + (long)a0 * ld, ld, 6, (char*)lds, a0 - 64, npos, tab, lse, (long)r * 8);
                }
            }
        }
    }
    SEAM(6);
    if (IN(7)) {
        for (int m = gw; m < MTOK; m += NGW) {
#pragma unroll
            for (int j = 0; j < 2; ++j) {
                const int e = j * 512 + lane * 8, h = e >> 7;
                const float l0 = LSE[((size_t)0 * MTOK + m) * 8 + h], l1 = LSE[((size_t)1 * MTOK + m) * 8 + h], l2 = LSE[((size_t)2 * MTOK + m) * 8 + h];
                const float mx = fmaxf(l0, fmaxf(l1, l2)); float w0 = __expf(l0 - mx), w1 = __expf(l1 - mx), w2 = __expf(l2 - mx);
                const float inv = 1.0f / (w0 + w1 + w2); w0 *= inv; w1 *= inv; w2 *= inv;
                const bf16r* p = PROJ + (size_t)m * INW + O_QB + e;
                const v4u a0 = *(const v4u*)p, a1 = *(const v4u*)(p + 1024), a2 = *(const v4u*)(p + 2048);
                v4u o;
#pragma unroll
                for (int q = 0; q < 4; ++q) {
                    const float x0 = __builtin_bit_cast(float, a0[q] << 16), y0 = __builtin_bit_cast(float, a0[q] & 0xffff0000u);
                    const float x1 = __builtin_bit_cast(float, a1[q] << 16), y1 = __builtin_bit_cast(float, a1[q] & 0xffff0000u);
                    const float x2 = __builtin_bit_cast(float, a2[q] << 16), y2 = __builtin_bit_cast(float, a2[q] & 0xffff0000u);
                    o[q] = pk2(w0 * x0 + w1 * x1 + w2 * x2, w0 * y0 + w1 * y1 + w2 * y2);
                }
                *(v4u*)(MIX + (size_t)m * DM + 1024 + e) = o;
            }
        }
    }
    SEAM(7);
    if (IN(8)) {
        pg8::Gemm g{MIX, WOUT, MTOK, DM, DM}; pg8::StaticOrder S; S.init(MTOK, DM, G, bx, 4);
        pg8::EpiRes<true, false, true> E{nullptr, H, nullptr, XB2, SS + MTOK, DM, 1.0f};
        pg8::gemm_phase<pg8::EpiRes<true, false, true>, pg8::StaticOrder, true, true>(ldsl, g, S, E);
    }
    SEAM(8);
    if (IN(10)) {
        pg8::Gemm g{XB2, WQM, MTOK, MEMW, DM}; pg8::StaticOrder S; S.init(MTOK, MEMW, G, bx);
        pg8::EpiBf16<true> E{QM, MEMW, SS + MTOK};
        pg8::gemm_phase<pg8::EpiBf16<true>, pg8::StaticOrder, true, true>(ldsl, g, S, E);
    }
    SEAM(10);
    if (IN(11)) {
        for (int u = vcu; u < 512; u += G) {
            const int qb = u >> 2, h = u & 3; const size_t rowq = (size_t)qb * 256; const int b = (int)(rowq / SEQ);
            const att::bf16* kv = (const att::bf16*)KVM + (size_t)b * MEMT * (2 * MEMW);
            att::attn_unit<0>((const att::bf16*)QM + rowq * MEMW + h * 128, MEMW, kv + h * 128, kv + MEMW + h * 128, 2 * MEMW,
                              (att::bf16*)OM + rowq * MEMW + h * 128, MEMW, MEMT / 64, (char*)lds, 0, 0, nullptr, nullptr, 0);
        }
    }
    SEAM(11);
    if (IN(12)) {
        pg8::Gemm g{OM, WOM, MTOK, DM, MEMW}; pg8::StaticOrder S; S.init(MTOK, DM, G, bx, 4);
        pg8::EpiRes<true, false, true> E{nullptr, XB2, nullptr, H, SS + 2 * MTOK, DM, 1.0f};
        pg8::gemm_phase<pg8::EpiRes<true, false, true>, pg8::StaticOrder, true, true>(ldsl, g, S, E);
    }
    SEAM(12);
    if (IN(14)) {
        pg8::Gemm g{H, WGU2, MTOK, 2 * DFF, DM}; pg8::StaticOrder S; S.init(MTOK, 2 * DFF, G, bx, 4);
        pg8::EpiSwiGLU<true> E{ACT, DFF, SS + 2 * MTOK};
        pg8::gemm_phase<pg8::EpiSwiGLU<true>, pg8::StaticOrder, true, true>(ldsl, g, S, E);
    }
    SEAM(14);
    if (IN(15)) {
        pg8::Gemm g{ACT, WD2, MTOK, DM, DFF}; pg8::StaticOrder S; S.init(MTOK, DM, G, bx, 4);
        pg8::EpiFinal E{H, out, SS + 3 * MTOK, PCNT, args.in[I_FIN], DM, 0.5f, (unsigned)(DM / 256)};
        pg8::gemm_phase<pg8::EpiFinal, pg8::StaticOrder, true, true>(ldsl, g, S, E);
    }
#undef IN
#undef SEAM
}

extern "C" void kernel_launch(void* const* d_in, const int* in_sizes, int n_in, void* d_out, int out_size, void* d_ws, size_t ws_size, hipStream_t stream) {
    static int grid = 0;
    if (grid == 0) {
        if (n_in != 22 || in_sizes[0] != MTOK * DM || out_size != MTOK * DM || ws_size < WS_END) {
            fprintf(stderr, "kernel_launch: unexpected shapes: n_in %d in0 %d out %d ws %zu (need >= %zu)\n", n_in, n_in > 0 ? in_sizes[0] : -1, out_size, ws_size, (size_t)WS_END); grid = -1; return; }
        int dev = 0, cus = 0, per_cu = 0;
        if (hipGetDevice(&dev) != hipSuccess || hipDeviceGetAttribute(&cus, hipDeviceAttributeMultiprocessorCount, dev) != hipSuccess) { fprintf(stderr, "kernel_launch: device query failed\n"); grid = -1; return; }
        if (hipFuncSetAttribute((const void*)mk_fwd, hipFuncAttributeMaxDynamicSharedMemorySize, LDS_BYTES) != hipSuccess) { fprintf(stderr, "kernel_launch: hipFuncSetAttribute failed\n"); grid = -1; return; }
        if (hipOccupancyMaxActiveBlocksPerMultiprocessor(&per_cu, (const void*)mk_fwd, NWAVES * 64, LDS_BYTES) != hipSuccess || per_cu < 1) { fprintf(stderr, "kernel_launch: occupancy query gave %d\n", per_cu); per_cu = 1; }
        (void)hipGetLastError();
        grid = cus * 1;
        fprintf(stderr, "kernel_launch: grid %d (cus %d, per_cu %d)\n", grid, cus, per_cu);
    }
    if (grid < 0) return;
    Args a{};
    for (int i = 0; i < 22; ++i) a.in[i] = (const float*)d_in[i];
    a.out = (float*)d_out; a.ws = (unsigned char*)d_ws;
    if (MK_N_LAUNCHES == 1) {
        a.ph_lo = 0; a.ph_hi = NPH;
        void* kargs[] = {&a};
        hipError_t e = hipLaunchCooperativeKernel((const void*)mk_fwd, dim3(grid), dim3(NWAVES * 64), kargs, LDS_BYTES, stream);
        if (e != hipSuccess) fprintf(stderr, "kernel_launch: cooperative launch failed: %s (grid %d)\n", hipGetErrorString(e), grid);
    } else {
        for (int p = 0; p < NPH; ++p) {
            a.ph_lo = p; a.ph_hi = p + 1;
            hipLaunchKernelGGL(mk_fwd, dim3(grid), dim3(NWAVES * 64), LDS_BYTES, stream, a);
        }
        hipError_t e = hipPeekAtLastError();
        if (e != hipSuccess) fprintf(stderr, "kernel_launch: launch failed: %s\n", hipGetErrorName(e));
    }
}
```

```cpp
#include <hip/hip_runtime.h>
#include <hip/hip_bf16.h>
#include <hip/hip_cooperative_groups.h>
#include <cstdio>
#include <cstdint>
#include <cmath>
namespace cg = cooperative_groups;

#ifndef ATT_SD0
#define ATT_SD0 2
#endif
#ifndef MK_N_LAUNCHES
#define MK_N_LAUNCHES 1
#endif

namespace pg8 {
#define PG8_LAS __attribute__((address_space(3)))
typedef unsigned short bf16_t;
typedef short bf16x8 __attribute__((ext_vector_type(8)));
typedef float f32x4 __attribute__((ext_vector_type(4)));
typedef unsigned u32x4 __attribute__((ext_vector_type(4)));
constexpr int BM = 256, BK = 64, HALF = 128, HTB = HALF * BK * 2, STAGE_BYTES = 8 * HTB, NXCD = 8, WGM = 8;

__host__ __device__ __forceinline__ int lds_byte(int r, int c) { const int st = (r >> 4) * 2 + (c >> 5), rr = r & 15, cc = c & 31, ob = rr * 64 + cc * 2; return st * 1024 + (ob ^ (((ob >> 9) & 1) << 5)); }
__host__ __device__ __forceinline__ void stage_rc(int b, int& R, int& C) { const int st = b / 1024, sb = b % 1024, swz = sb ^ (((sb >> 9) & 1) << 5); R = (st >> 1) * 16 + swz / 64; C = (st & 1) * 32 + (swz % 64) / 2; }
__host__ __device__ __forceinline__ int perm32(int rho) { const int n = rho >> 4, i = rho & 15; return 8 * (i >> 2) + 4 * n + (i & 3); }

struct Unit { int pm, pn; };
struct Gemm { const bf16_t* A; const bf16_t* Bt; int M, N, K; };

struct StaticOrder {
    int nM, nN, nwg, G, c, wgm;
    __host__ __device__ void init(int M, int N, int G_, int c_, int wgm_ = WGM) { nM = M / BM; nN = N / BM; nwg = nM * nN; G = G_; c = c_; wgm = wgm_; }
    __host__ __device__ bool next(int i, Unit& u) const {
        const long L = (long)i * G + c; if (L >= nwg) return false;
        int wgid = (int)L; { const int q = nwg / NXCD, r = nwg % NXCD, xcd = wgid % NXCD, off = wgid / NXCD; wgid = (xcd < r ? xcd * (q + 1) : r * (q + 1) + (xcd - r) * q) + off; }
        const int nig = wgm * nN, gid = wgid / nig, fm = gid * wgm, gsz = (nM - fm) < wgm ? (nM - fm) : wgm;
        u.pm = fm + ((wgid % nig) % gsz); u.pn = (wgid % nig) / gsz; return true;
    }
    __device__ __forceinline__ void a_ready(const Unit&) const {}
    __device__ __forceinline__ void done(const Unit&) const {}
};

__device__ __forceinline__ unsigned cvt_pk_bf16(float lo, float hi) { unsigned r; asm volatile("v_cvt_pk_bf16_f32 %0, %1, %2" : "=v"(r) : "v"(lo), "v"(hi)); return r; }

template <bool NORM> struct EpiBf16 {
    static constexpr bool PERM = true, AFTER_DRAIN = false;
    bf16_t* O; int ldc; const float* ss;
    __device__ __forceinline__ void operator()(const f32x4 (&acc)[2][2][4][2], const Unit& u, int wr, int wc, int fr, int fq) const {
        const int row0 = u.pm * BM + wr * 64 + fr; const int col0 = u.pn * BM + wc * 32 + 8 * fq;
#pragma unroll
        for (int ai = 0; ai < 2; ++ai)
#pragma unroll
            for (int m = 0; m < 4; ++m) { const int row = row0 + ai * HALF + m * 16; bf16_t* rowp = O + (size_t)row * ldc + col0;
                float rs = 1.0f; if constexpr (NORM) rs = 1.0f / sqrtf(ss[row] * (1.0f / 2048.0f) + 1e-6f);
#pragma unroll
                for (int bj = 0; bj < 2; ++bj) { const f32x4 v0 = acc[ai][bj][m][0] * rs, v1 = acc[ai][bj][m][1] * rs;
                    u32x4 w; w.x = cvt_pk_bf16(v0[0], v0[1]); w.y = cvt_pk_bf16(v0[2], v0[3]); w.z = cvt_pk_bf16(v1[0], v1[1]); w.w = cvt_pk_bf16(v1[2], v1[3]);
                    *(u32x4*)(rowp + bj * HALF) = w; } }
    }
};
template <bool NORM> struct EpiSwiGLU {
    static constexpr bool PERM = true, AFTER_DRAIN = false;
    bf16_t* O; int ldc; const float* ss;
    __device__ __forceinline__ float act(float g, float u) const { const float e = __builtin_amdgcn_exp2f(-g * 1.4426950408889634f); return g * u * __builtin_amdgcn_rcpf(1.0f + e); }
    __device__ __forceinline__ void operator()(const f32x4 (&acc)[2][2][4][2], const Unit& u, int wr, int wc, int fr, int fq) const {
        const int row0 = u.pm * BM + wr * 64 + fr; const int col0 = u.pn * HALF + wc * 32 + 8 * fq;
#pragma unroll
        for (int ai = 0; ai < 2; ++ai)
#pragma unroll
            for (int m = 0; m < 4; ++m) { const int row = row0 + ai * HALF + m * 16; bf16_t* rowp = O + (size_t)row * ldc + col0;
                float rs = 1.0f; if constexpr (NORM) rs = 1.0f / sqrtf(ss[row] * (1.0f / 2048.0f) + 1e-6f);
                const f32x4 g0 = acc[ai][0][m][0] * rs, g1 = acc[ai][0][m][1] * rs, u0 = acc[ai][1][m][0] * rs, u1 = acc[ai][1][m][1] * rs;
                u32x4 w; w.x = cvt_pk_bf16(act(g0[0], u0[0]), act(g0[1], u0[1])); w.y = cvt_pk_bf16(act(g0[2], u0[2]), act(g0[3], u0[3]));
                w.z = cvt_pk_bf16(act(g1[0], u1[0]), act(g1[1], u1[1])); w.w = cvt_pk_bf16(act(g1[2], u1[2]), act(g1[3], u1[3]));
                *(u32x4*)rowp = w; }
    }
};
template <bool BASE_BF16, bool WRITE_F32, bool WRITE_XB> struct EpiRes {
    static constexpr bool PERM = true, AFTER_DRAIN = false;
    const float* base; const bf16_t* baseb; float* out; bf16_t* xb; float* ss; int ldc; float alpha;
    __device__ __forceinline__ void operator()(const f32x4 (&acc)[2][2][4][2], const Unit& u, int wr, int wc, int fr, int fq) const {
        const int row0 = u.pm * BM + wr * 64 + fr; const int col0 = u.pn * BM + wc * 32 + 8 * fq;
#pragma unroll
        for (int ai = 0; ai < 2; ++ai)
#pragma unroll
            for (int m = 0; m < 4; ++m) { const int row = row0 + ai * HALF + m * 16; const size_t off = (size_t)row * ldc + col0; float part = 0.f;
#pragma unroll
                for (int bj = 0; bj < 2; ++bj) { const size_t idx = off + bj * HALF;
                    f32x4 b0, b1;
                    if constexpr (BASE_BF16) { const u32x4 r = *(const u32x4*)(baseb + idx);
                        b0 = (f32x4){__builtin_bit_cast(float, r.x << 16), __builtin_bit_cast(float, r.x & 0xffff0000u), __builtin_bit_cast(float, r.y << 16), __builtin_bit_cast(float, r.y & 0xffff0000u)};
                        b1 = (f32x4){__builtin_bit_cast(float, r.z << 16), __builtin_bit_cast(float, r.z & 0xffff0000u), __builtin_bit_cast(float, r.w << 16), __builtin_bit_cast(float, r.w & 0xffff0000u)}; }
                    else { b0 = *(const f32x4*)(base + idx); b1 = *(const f32x4*)(base + idx + 4); }
                    const f32x4 o0 = b0 + acc[ai][bj][m][0] * alpha, o1 = b1 + acc[ai][bj][m][1] * alpha;
                    if constexpr (WRITE_F32) { *(f32x4*)(out + idx) = o0; *(f32x4*)(out + idx + 4) = o1; }
                    if constexpr (WRITE_XB) {
                        part += (o0[0] * o0[0] + o0[1] * o0[1]) + (o0[2] * o0[2] + o0[3] * o0[3]) + (o1[0] * o1[0] + o1[1] * o1[1]) + (o1[2] * o1[2] + o1[3] * o1[3]);
                        u32x4 w; w.x = cvt_pk_bf16(o0[0], o0[1]); w.y = cvt_pk_bf16(o0[2], o0[3]); w.z = cvt_pk_bf16(o1[0], o1[1]); w.w = cvt_pk_bf16(o1[2], o1[3]);
                        *(u32x4*)(xb + idx) = w; } }
                if constexpr (WRITE_XB) { part += __shfl_xor(part, 16); part += __shfl_xor(part, 32);
                    if (fq == 0) atomicAdd(ss + row, part); } }
    }
};
struct EpiFinal {
    static constexpr bool PERM = true, AFTER_DRAIN = false;
    const bf16_t* baseb; float* out; float* ss; unsigned* cnt; const float* gain; int ldc; float alpha; unsigned ntn;
    __device__ __forceinline__ void tile(const f32x4 (&acc)[2][2][4][2], int ai, int m, int bj, size_t idx, f32x4& o0, f32x4& o1) const {
        const u32x4 r = *(const u32x4*)(baseb + idx);
        const f32x4 b0 = (f32x4){__builtin_bit_cast(float, r.x << 16), __builtin_bit_cast(float, r.x & 0xffff0000u), __builtin_bit_cast(float, r.y << 16), __builtin_bit_cast(float, r.y & 0xffff0000u)};
        const f32x4 b1 = (f32x4){__builtin_bit_cast(float, r.z << 16), __builtin_bit_cast(float, r.z & 0xffff0000u), __builtin_bit_cast(float, r.w << 16), __builtin_bit_cast(float, r.w & 0xffff0000u)};
        o0 = b0 + acc[ai][bj][m][0] * alpha; o1 = b1 + acc[ai][bj][m][1] * alpha;
    }
    __device__ __forceinline__ void operator()(const f32x4 (&acc)[2][2][4][2], const Unit& u, int wr, int wc, int fr, int fq) const {
        const int row0 = u.pm * BM + wr * 64 + fr; const int col0 = u.pn * BM + wc * 32 + 8 * fq;
#pragma unroll
        for (int ai = 0; ai < 2; ++ai)
#pragma unroll
            for (int m = 0; m < 4; ++m) { const int row = row0 + ai * HALF + m * 16; const size_t off = (size_t)row * ldc + col0; float part = 0.f;
#pragma unroll
                for (int bj = 0; bj < 2; ++bj) { f32x4 o0, o1; tile(acc, ai, m, bj, off + bj * HALF, o0, o1);
                    part += (o0[0] * o0[0] + o0[1] * o0[1]) + (o0[2] * o0[2] + o0[3] * o0[3]) + (o1[0] * o1[0] + o1[1] * o1[1]) + (o1[2] * o1[2] + o1[3] * o1[3]); }
                part += __shfl_xor(part, 16); part += __shfl_xor(part, 32);
                if (fq == 0) atomicAdd(ss + row, part); }
        asm volatile("s_waitcnt vmcnt(0)" ::: "memory");
        __builtin_amdgcn_s_barrier();
        if (threadIdx.x == 0) {
            unsigned* c = cnt + 64 * u.pm;
            __hip_atomic_fetch_add(c, 1u, __ATOMIC_RELAXED, __HIP_MEMORY_SCOPE_AGENT);
            unsigned sp = 0;
            while (__hip_atomic_load(c, __ATOMIC_RELAXED, __HIP_MEMORY_SCOPE_AGENT) < ntn) { __builtin_amdgcn_s_sleep(2); if (++sp > (1u << 22)) break; }
        }
        asm volatile("s_waitcnt vmcnt(0) lgkmcnt(0)" ::: "memory");
        __builtin_amdgcn_s_barrier(); asm volatile("" ::: "memory");
        f32x4 gv[2][2];
#pragma unroll
        for (int bj = 0; bj < 2; ++bj) { gv[bj][0] = *(const f32x4*)(gain + col0 + bj * HALF); gv[bj][1] = *(const f32x4*)(gain + col0 + bj * HALF + 4); }
#pragma unroll
        for (int ai = 0; ai < 2; ++ai)
#pragma unroll
            for (int m = 0; m < 4; ++m) { const int row = row0 + ai * HALF + m * 16; const size_t off = (size_t)row * ldc + col0;
                const float sv = __hip_atomic_load(ss + row, __ATOMIC_RELAXED, __HIP_MEMORY_SCOPE_AGENT);
                const float rs = 1.0f / sqrtf(sv * (1.0f / 2048.0f) + 1e-6f);
#pragma unroll
                for (int bj = 0; bj < 2; ++bj) { f32x4 o0, o1; const size_t idx = off + bj * HALF; tile(acc, ai, m, bj, idx, o0, o1);
                    *(f32x4*)(out + idx) = o0 * rs * gv[bj][0]; *(f32x4*)(out + idx + 4) = o1 * rs * gv[bj][1]; } }
    }
};
struct EpiResidX {
    static constexpr bool PERM = true, AFTER_DRAIN = false;
    const float* base; float* out; bf16_t* xb; float* ss; int ldc; float alpha;
    __device__ __forceinline__ void operator()(const f32x4 (&acc)[2][2][4][2], const Unit& u, int wr, int wc, int fr, int fq) const {
        const int row0 = u.pm * BM + wr * 64 + fr; const int col0 = u.pn * BM + wc * 32 + 8 * fq;
#pragma unroll
        for (int ai = 0; ai < 2; ++ai)
#pragma unroll
            for (int m = 0; m < 4; ++m) { const int row = row0 + ai * HALF + m * 16; const size_t off = (size_t)row * ldc + col0; float part = 0.f;
#pragma unroll
                for (int bj = 0; bj < 2; ++bj) { const size_t idx = off + bj * HALF;
                    const f32x4 b0 = *(const f32x4*)(base + idx), b1 = *(const f32x4*)(base + idx + 4);
                    const f32x4 o0 = b0 + acc[ai][bj][m][0] * alpha, o1 = b1 + acc[ai][bj][m][1] * alpha;
                    *(f32x4*)(out + idx) = o0; *(f32x4*)(out + idx + 4) = o1;
                    part += (o0[0] * o0[0] + o0[1] * o0[1]) + (o0[2] * o0[2] + o0[3] * o0[3]) + (o1[0] * o1[0] + o1[1] * o1[1]) + (o1[2] * o1[2] + o1[3] * o1[3]);
                    u32x4 w; w.x = cvt_pk_bf16(o0[0], o0[1]); w.y = cvt_pk_bf16(o0[2], o0[3]); w.z = cvt_pk_bf16(o1[0], o1[1]); w.w = cvt_pk_bf16(o1[2], o1[3]);
                    *(u32x4*)(xb + idx) = w; }
                part += __shfl_xor(part, 16); part += __shfl_xor(part, 32);
                if (fq == 0) atomicAdd(ss + row, part); }
    }
};
struct EpiResid {
    static constexpr bool PERM = false, AFTER_DRAIN = false;
    const float* base; float* out; int ldc; float alpha;
    __device__ __forceinline__ void operator()(const f32x4 (&acc)[2][2][4][2], const Unit& u, int wr, int wc, int fr, int fq) const {
        const int row0 = u.pm * BM + wr * 64 + fr; const int col0 = u.pn * BM + wc * 32 + 4 * fq;
#pragma unroll
        for (int ai = 0; ai < 2; ++ai)
#pragma unroll
            for (int m = 0; m < 4; ++m) { const size_t off = (size_t)(row0 + ai * HALF + m * 16) * ldc + col0;
#pragma unroll
                for (int bj = 0; bj < 2; ++bj)
#pragma unroll
                    for (int n = 0; n < 2; ++n) { const size_t idx = off + bj * HALF + n * 16; const f32x4 b = *(const f32x4*)(base + idx);
                        *(f32x4*)(out + idx) = b + acc[ai][bj][m][n] * alpha; } }
    }
};

template <class Epi, class Sched, bool ALIGN_EPI = false, bool SP2 = false>
__device__ __forceinline__ void gemm_phase(PG8_LAS unsigned char* lds, const Gemm g, const Sched& S, const Epi& E) {
    int tid = threadIdx.x; asm volatile("" : "+v"(tid));
    const int wid = __builtin_amdgcn_readfirstlane(tid >> 6), lane = tid & 63, wr = wid >> 2, wc = wid & 3, fr = lane & 15, fq = lane >> 4;
    const int K = g.K, nt = K / BK;
    unsigned voffA[2], voffB[2];
#pragma unroll
    for (int i = 0; i < 2; ++i) { int R, C; stage_rc(tid * 16 + i * 8192, R, C); const int Rb = Epi::PERM ? ((R & ~31) + perm32(R & 31)) : R;
        voffA[i] = (unsigned)(R * K + C) * 2u; voffB[i] = (unsigned)(Rb * K + C) * 2u; }
    const size_t kstep = (size_t)(BK * 2);
    const size_t hstep = (size_t)HALF * K * 2;
    const size_t tstep = 2 * hstep;
    const unsigned ldsw = (unsigned)wid * 1024u;
    const int aoff = lds_byte(wr * 64 + fr, fq * 8), boff = lds_byte(wc * 32 + fr, fq * 8);
#define PG8_SA(b, h) (((b) * 2 + (h)) * HTB)
#define PG8_SB(b, h) ((4 + (b) * 2 + (h)) * HTB)
#define PG8_STAGE(bufoff, gbase, voff) do { _Pragma("unroll") for (int _i = 0; _i < 2; ++_i) \
        __builtin_amdgcn_global_load_lds((const unsigned*)((const char*)(gbase) + (voff)[_i]), (PG8_LAS unsigned*)(lds + (bufoff) + ldsw + _i * 8192), 16, 0, 0); } while (0)
#define PG8_LDA(dst, b, h) do { _Pragma("unroll") for (int m = 0; m < 4; ++m) _Pragma("unroll") for (int k = 0; k < 2; ++k) dst[m][k] = *(const PG8_LAS bf16x8*)(lds + PG8_SA(b, h) + aoff + m * 2048 + k * 1024); } while (0)
#define PG8_LDB(dst, b, h) do { _Pragma("unroll") for (int n = 0; n < 2; ++n) _Pragma("unroll") for (int k = 0; k < 2; ++k) dst[n][k] = *(const PG8_LAS bf16x8*)(lds + PG8_SB(b, h) + boff + n * 2048 + k * 1024); } while (0)
#define PG8_MMA(ai, bj, At, Bt) do { __builtin_amdgcn_s_setprio(1); _Pragma("unroll") for (int m = 0; m < 4; ++m) _Pragma("unroll") for (int n = 0; n < 2; ++n) _Pragma("unroll") for (int k = 0; k < 2; ++k) \
        acc[ai][bj][m][n] = __builtin_amdgcn_mfma_f32_16x16x32_bf16(Bt[n][k], At[m][k], acc[ai][bj][m][n], 0, 0, 0); __builtin_amdgcn_s_setprio(0); } while (0)
#define PG8_WAIT_V(n) asm volatile("s_waitcnt vmcnt(" #n ")" ::: "memory")
#define PG8_WAIT_L(n) asm volatile("s_waitcnt lgkmcnt(" #n ")" ::: "memory")
#define PG8_BAR __builtin_amdgcn_s_barrier()
#define PG8_SCHED __builtin_amdgcn_sched_barrier(0)
    Unit cur, nxt; int ui = 0;
    if (!S.next(0, cur)) return;
    f32x4 acc[2][2][4][2];
#pragma unroll
    for (int a = 0; a < 2; ++a)
#pragma unroll
        for (int b = 0; b < 2; ++b)
#pragma unroll
            for (int m = 0; m < 4; ++m)
#pragma unroll
                for (int n = 0; n < 2; ++n) acc[a][b][m][n] = (f32x4){0.f, 0.f, 0.f, 0.f};
    bf16x8 At[4][2], B0[2][2], B1[2][2];
    const char* cA = (const char*)g.A + (size_t)cur.pm * tstep; const char* cB = (const char*)g.Bt + (size_t)cur.pn * tstep;
    S.a_ready(cur);
    if constexpr (SP2) {
        PG8_STAGE(PG8_SB(0, 0), cB, voffB); PG8_STAGE(PG8_SB(0, 1), cB + hstep, voffB); PG8_STAGE(PG8_SA(0, 0), cA, voffA); PG8_STAGE(PG8_SA(0, 1), cA + hstep, voffA);
        if (wr == 1) PG8_BAR;
        PG8_WAIT_V(2); PG8_BAR;
        PG8_STAGE(PG8_SB(1, 0), cB + kstep, voffB); PG8_STAGE(PG8_SA(1, 0), cA + kstep, voffA); PG8_STAGE(PG8_SB(1, 1), cB + hstep + kstep, voffB);
        PG8_WAIT_V(6); PG8_BAR;
    } else {
        PG8_STAGE(PG8_SB(0, 0), cB, voffB); PG8_STAGE(PG8_SA(0, 0), cA, voffA); PG8_STAGE(PG8_SB(0, 1), cB + hstep, voffB); PG8_STAGE(PG8_SA(0, 1), cA + hstep, voffA);
        if (wr == 1) PG8_BAR;
        PG8_WAIT_V(4); PG8_BAR;
        PG8_STAGE(PG8_SB(1, 0), cB + kstep, voffB); PG8_STAGE(PG8_SA(1, 0), cA + kstep, voffA); PG8_STAGE(PG8_SB(1, 1), cB + hstep + kstep, voffB);
        PG8_WAIT_V(6); PG8_BAR;
    }
    for (;;) {
        const bool has_next = S.next(ui + 1, nxt);
        const char* nA = has_next ? (const char*)g.A + (size_t)nxt.pm * tstep : cA; const char* nB = has_next ? (const char*)g.Bt + (size_t)nxt.pn * tstep : cB;
        for (int t = 0; t < nt; t += 2) {
            const bool last = (t == nt - 2);
            const char* a1 = cA + (size_t)(t + 1) * kstep;
            const char* a2 = last ? nA : cA + (size_t)(t + 2) * kstep; const char* b2 = last ? nB : cB + (size_t)(t + 2) * kstep;
            const char* a3 = a2 + kstep; const char* b3 = b2 + kstep;
            if (last && has_next) S.a_ready(nxt);
            if constexpr (SP2) {
            PG8_LDB(B0, 0, 0); PG8_LDB(B1, 0, 1); PG8_SCHED; PG8_LDA(At, 0, 0); PG8_STAGE(PG8_SA(1, 1), a1 + hstep, voffA);
            PG8_WAIT_V(8); PG8_WAIT_L(0); PG8_BAR; PG8_MMA(0, 0, At, B0); PG8_MMA(0, 1, At, B1); PG8_BAR; PG8_SCHED;
            PG8_LDA(At, 0, 1); PG8_STAGE(PG8_SB(0, 0), b2, voffB); PG8_STAGE(PG8_SB(0, 1), b2 + hstep, voffB); PG8_STAGE(PG8_SA(0, 0), a2, voffA);
            PG8_WAIT_V(8); PG8_WAIT_L(0); PG8_BAR; PG8_MMA(1, 0, At, B0); PG8_MMA(1, 1, At, B1); PG8_BAR; PG8_SCHED;
            PG8_LDB(B0, 1, 0); PG8_LDB(B1, 1, 1); PG8_SCHED; PG8_LDA(At, 1, 0); PG8_STAGE(PG8_SA(0, 1), a2 + hstep, voffA);
            PG8_WAIT_V(8); PG8_WAIT_L(0); PG8_BAR; PG8_MMA(0, 0, At, B0); PG8_MMA(0, 1, At, B1); PG8_BAR; PG8_SCHED;
            PG8_LDA(At, 1, 1); PG8_STAGE(PG8_SB(1, 0), b3, voffB); PG8_STAGE(PG8_SB(1, 1), b3 + hstep, voffB); PG8_STAGE(PG8_SA(1, 0), a3, voffA);
            PG8_WAIT_V(8); PG8_WAIT_L(0); PG8_BAR; PG8_MMA(1, 0, At, B0); PG8_MMA(1, 1, At, B1); PG8_BAR; PG8_SCHED;
            } else {
            PG8_LDB(B0, 0, 0); PG8_SCHED; PG8_LDA(At, 0, 0); PG8_STAGE(PG8_SA(1, 1), a1 + hstep, voffA);
            PG8_WAIT_L(8); PG8_BAR; PG8_WAIT_L(0); PG8_MMA(0, 0, At, B0); PG8_BAR; PG8_SCHED;
            PG8_LDB(B1, 0, 1); PG8_STAGE(PG8_SB(0, 0), b2, voffB);
            PG8_BAR; PG8_WAIT_L(0); PG8_MMA(0, 1, At, B1); PG8_BAR;
            PG8_LDA(At, 0, 1); PG8_STAGE(PG8_SA(0, 0), a2, voffA);
            PG8_BAR; PG8_WAIT_L(0); PG8_MMA(1, 0, At, B0); PG8_BAR; PG8_SCHED;
            PG8_STAGE(PG8_SB(0, 1), b2 + hstep, voffB);
            PG8_WAIT_V(6); PG8_BAR; PG8_MMA(1, 1, At, B1); PG8_BAR;
            PG8_LDB(B0, 1, 0); PG8_SCHED; PG8_LDA(At, 1, 0); PG8_STAGE(PG8_SA(0, 1), a2 + hstep, voffA);
            PG8_WAIT_L(8); PG8_BAR; PG8_WAIT_L(0); PG8_MMA(0, 0, At, B0); PG8_BAR; PG8_SCHED;
            PG8_LDB(B1, 1, 1); PG8_STAGE(PG8_SB(1, 0), b3, voffB);
            PG8_BAR; PG8_WAIT_L(0); PG8_MMA(0, 1, At, B1); PG8_BAR;
            PG8_LDA(At, 1, 1); PG8_STAGE(PG8_SA(1, 0), a3, voffA);
            PG8_BAR; PG8_WAIT_L(0); PG8_MMA(1, 0, At, B0); PG8_BAR; PG8_SCHED;
            PG8_STAGE(PG8_SB(1, 1), b3 + hstep, voffB);
            PG8_WAIT_V(6); PG8_BAR; PG8_MMA(1, 1, At, B1); PG8_BAR;
            }
        }
        if constexpr (ALIGN_EPI) { if (wr == 0) PG8_BAR; }
        if constexpr (!Epi::AFTER_DRAIN) { E(acc, cur, wr, wc, fr, fq); S.done(cur); }
        if (!has_next) break;
#pragma unroll
        for (int a = 0; a < 2; ++a)
#pragma unroll
            for (int b = 0; b < 2; ++b)
#pragma unroll
                for (int m = 0; m < 4; ++m)
#pragma unroll
                    for (int n = 0; n < 2; ++n) acc[a][b][m][n] = (f32x4){0.f, 0.f, 0.f, 0.f};
        cur = nxt; cA = nA; cB = nB; ++ui;
        if constexpr (ALIGN_EPI) { if (wr == 1) PG8_BAR; }
    }
    PG8_WAIT_V(0);
    if constexpr (!ALIGN_EPI) { if (wr == 0) PG8_BAR; }
    PG8_BAR;
#undef PG8_SA
#undef PG8_SB
#undef PG8_STAGE
#undef PG8_LDA
#undef PG8_LDB
#undef PG8_MMA
#undef PG8_WAIT_V
#undef PG8_WAIT_L
#undef PG8_BAR
#undef PG8_SCHED
}
}

namespace att {
using bf16 = __hip_bfloat16;
constexpr int D = 128, NW = 8, QBLK = 32, KVBLK = 64;
constexpr float SCALE = 0.088388347648318440f;
constexpr float THR = 8.f;
constexpr size_t SHM_V = KVBLK * D * 2, SHM_K = KVBLK * D * 2, SHM_ATTN = 2 * SHM_V + 2 * SHM_K + NW * 64 * 4;
constexpr int TAB_N = 640, TAB_PAD = 320;
using bf16x8 = __attribute__((ext_vector_type(8))) short;
using s16x4  = __attribute__((ext_vector_type(4))) short;
using f32x16 = __attribute__((ext_vector_type(16))) float;
using u32x4  = __attribute__((ext_vector_type(4))) unsigned;
#define KSWZ(row, colB) ((row) * 256 + ((colB) ^ (((row) & 7) << 4)))
#define SBAR() __builtin_amdgcn_sched_barrier(0)
__device__ __forceinline__ int crow(int r, int hi) { return (r & 3) + 8 * (r >> 2) + 4 * hi; }
__device__ __forceinline__ unsigned cvtpk(float lo, float hi) { unsigned r; asm volatile("v_cvt_pk_bf16_f32 %0, %1, %2" : "=v"(r) : "v"(lo), "v"(hi)); return r; }

__device__ __forceinline__ void partialSM(f32x16& p0, f32x16& p1, float& m_reg, float& mn, float& alpha) {
  constexpr float C = SCALE * 1.4426950408889634f;
  float pmax = p0[0];
#pragma unroll
  for (int r = 1; r < 16; ++r) pmax = fmaxf(pmax, p0[r]);
#pragma unroll
  for (int r = 0; r < 16; ++r) pmax = fmaxf(pmax, p1[r]);
  { auto rr = __builtin_amdgcn_permlane32_swap(__float_as_uint(pmax), __float_as_uint(pmax), false, false);
    pmax = fmaxf(__uint_as_float(rr[0]), __uint_as_float(rr[1])); }
  if (__builtin_expect(__all(pmax - m_reg <= THR / SCALE), 1)) { mn = m_reg; alpha = 1.f; }
  else { mn = fmaxf(m_reg, pmax); alpha = __builtin_amdgcn_exp2f((m_reg - mn) * C); m_reg = mn; }
  float mnC = -mn * C;
#pragma unroll
  for (int r = 0; r < 16; ++r) p0[r] = fmaf(p0[r], C, mnC);
#pragma unroll
  for (int r = 0; r < 16; ++r) p1[r] = fmaf(p1[r], C, mnC);
#pragma unroll
  for (int r = 0; r < 16; ++r) p0[r] = __builtin_amdgcn_exp2f(p0[r]);
}
__device__ __forceinline__ void partialSM_pre(f32x16& p0, f32x16& p1, float& m_reg, float& mn, float& alpha) {
  constexpr float C = SCALE * 1.4426950408889634f;
  float pmax = p0[0];
#pragma unroll
  for (int r = 1; r < 16; ++r) pmax = fmaxf(pmax, p0[r]);
#pragma unroll
  for (int r = 0; r < 16; ++r) pmax = fmaxf(pmax, p1[r]);
  { auto rr = __builtin_amdgcn_permlane32_swap(__float_as_uint(pmax), __float_as_uint(pmax), false, false);
    pmax = fmaxf(__uint_as_float(rr[0]), __uint_as_float(rr[1])); }
  if (__builtin_expect(__all(pmax - m_reg <= THR / SCALE), 1)) { mn = m_reg; alpha = 1.f; }
  else { mn = fmaxf(m_reg, pmax); alpha = __builtin_amdgcn_exp2f((m_reg - mn) * C); m_reg = mn; }
  float mnC = -mn * C;
#pragma unroll
  for (int r = 0; r < 16; ++r) p0[r] = fmaf(p0[r], C, mnC);
#pragma unroll
  for (int r = 0; r < 16; ++r) p1[r] = fmaf(p1[r], C, mnC);
}
__device__ __forceinline__ void finishSM(f32x16& p0, f32x16& p1, float alpha, float& l_reg, bf16x8& pa0, bf16x8& pa1, bf16x8& pa2, bf16x8& pa3) {
#pragma unroll
  for (int r = 0; r < 16; ++r) p1[r] = __builtin_amdgcn_exp2f(p1[r]);
  float ps = 0;
#pragma unroll
  for (int r = 0; r < 16; ++r) ps += p0[r];
#pragma unroll
  for (int r = 0; r < 16; ++r) ps += p1[r];
  { auto rr = __builtin_amdgcn_permlane32_swap(__float_as_uint(ps), __float_as_uint(ps), false, false);
    ps = __uint_as_float(rr[0]) + __uint_as_float(rr[1]); }
  l_reg = l_reg * alpha + ps;
#define PK4(P, BASE, OUT) do { unsigned a0 = cvtpk(P[BASE + 0], P[BASE + 1]), a1 = cvtpk(P[BASE + 2], P[BASE + 3]);   \
    unsigned b0 = cvtpk(P[BASE + 4], P[BASE + 5]), b1 = cvtpk(P[BASE + 6], P[BASE + 7]);                              \
    auto r0 = __builtin_amdgcn_permlane32_swap(a0, b0, false, false); auto r1 = __builtin_amdgcn_permlane32_swap(a1, b1, false, false); \
    u32x4 w = {r0[0], r1[0], r0[1], r1[1]}; OUT = *reinterpret_cast<bf16x8*>(&w); } while (0)
  PK4(p0, 0, pa0); PK4(p0, 8, pa1); PK4(p1, 0, pa2); PK4(p1, 8, pa3);
#undef PK4
}
__device__ __forceinline__ void qkt(f32x16& p0, f32x16& p1, const bf16* Ks, const bf16x8* qr, int r32, int hi) {
  p0 = f32x16{}; p1 = f32x16{};
#pragma unroll
  for (int d0 = 0; d0 < 8; ++d0) { int cb = (d0 * 16 + hi * 8) * 2;
    bf16x8 b0 = *reinterpret_cast<const bf16x8*>((const char*)Ks + KSWZ(r32, cb));
    bf16x8 b1 = *reinterpret_cast<const bf16x8*>((const char*)Ks + KSWZ(32 + r32, cb));
    p0 = __builtin_amdgcn_mfma_f32_32x32x16_bf16(b0, qr[d0], p0, 0, 0, 0);
    p1 = __builtin_amdgcn_mfma_f32_32x32x16_bf16(b1, qr[d0], p1, 0, 0, 0); }
}
__device__ __forceinline__ int v_st(int k, int c) { const int kk = (k & ~0xC) | ((k & 4) << 1) | ((k & 8) >> 1); return ((kk >> 3) * 4 + (c >> 5)) * 512 + ((kk & 7) * 32 + (c & 31)) * 2; }
__device__ __forceinline__ int v_rd_base(int lane) { return ((lane & 3) << 3) | (((lane >> 2) & 3) << 6) | (((lane >> 4) & 1) << 5) | (((lane >> 5) & 1) << 8); }
constexpr int v_rd_off(int d0, int ks, int half) { return d0 * 512 + ks * 4096 + half * 2048; }
template <int OFF> __device__ __forceinline__ s16x4 tr_read(int vb) {
  s16x4 r; asm volatile("ds_read_b64_tr_b16 %0, %1 offset:%2" : "=&v"(r) : "v"(vb), "i"(OFF) : "memory"); return r;
}
template <int D0> __device__ __forceinline__ void pv_one(f32x16& od, int vb, bf16x8 pa0, bf16x8 pa1, bf16x8 pa2, bf16x8 pa3) {
  const s16x4 l0 = tr_read<v_rd_off(D0, 0, 0)>(vb), h0 = tr_read<v_rd_off(D0, 0, 1)>(vb), l1 = tr_read<v_rd_off(D0, 1, 0)>(vb), h1 = tr_read<v_rd_off(D0, 1, 1)>(vb);
  const s16x4 l2 = tr_read<v_rd_off(D0, 2, 0)>(vb), h2 = tr_read<v_rd_off(D0, 2, 1)>(vb), l3 = tr_read<v_rd_off(D0, 3, 0)>(vb), h3 = tr_read<v_rd_off(D0, 3, 1)>(vb);
  asm volatile("s_waitcnt lgkmcnt(0)" ::: "memory"); SBAR();
#define PK(L, H) (bf16x8){L[0], L[1], L[2], L[3], H[0], H[1], H[2], H[3]}
  od = __builtin_amdgcn_mfma_f32_32x32x16_bf16(pa0, PK(l0, h0), od, 0, 0, 0);
  od = __builtin_amdgcn_mfma_f32_32x32x16_bf16(pa1, PK(l1, h1), od, 0, 0, 0);
  od = __builtin_amdgcn_mfma_f32_32x32x16_bf16(pa2, PK(l2, h2), od, 0, 0, 0);
  od = __builtin_amdgcn_mfma_f32_32x32x16_bf16(pa3, PK(l3, h3), od, 0, 0, 0);
#undef PK
}
template <int D0> __device__ __forceinline__ void pv_one_sm(f32x16& od, int vb, bf16x8 pa0, bf16x8 pa1, bf16x8 pa2, bf16x8 pa3, f32x16& P) {
  const s16x4 l0 = tr_read<v_rd_off(D0, 0, 0)>(vb), h0 = tr_read<v_rd_off(D0, 0, 1)>(vb), l1 = tr_read<v_rd_off(D0, 1, 0)>(vb), h1 = tr_read<v_rd_off(D0, 1, 1)>(vb);
  const s16x4 l2 = tr_read<v_rd_off(D0, 2, 0)>(vb), h2 = tr_read<v_rd_off(D0, 2, 1)>(vb), l3 = tr_read<v_rd_off(D0, 3, 0)>(vb), h3 = tr_read<v_rd_off(D0, 3, 1)>(vb);
  asm volatile("s_waitcnt lgkmcnt(0)" ::: "memory"); SBAR();
#define PK(L, H) (bf16x8){L[0], L[1], L[2], L[3], H[0], H[1], H[2], H[3]}
  od = __builtin_amdgcn_mfma_f32_32x32x16_bf16(pa0, PK(l0, h0), od, 0, 0, 0);
  P[4 * D0 + 0] = __builtin_amdgcn_exp2f(P[4 * D0 + 0]);
  od = __builtin_amdgcn_mfma_f32_32x32x16_bf16(pa1, PK(l1, h1), od, 0, 0, 0);
  P[4 * D0 + 1] = __builtin_amdgcn_exp2f(P[4 * D0 + 1]);
  od = __builtin_amdgcn_mfma_f32_32x32x16_bf16(pa2, PK(l2, h2), od, 0, 0, 0);
  P[4 * D0 + 2] = __builtin_amdgcn_exp2f(P[4 * D0 + 2]);
  od = __builtin_amdgcn_mfma_f32_32x32x16_bf16(pa3, PK(l3, h3), od, 0, 0, 0);
  P[4 * D0 + 3] = __builtin_amdgcn_exp2f(P[4 * D0 + 3]);
#undef PK
}
__device__ __forceinline__ void pv_d0_sm(f32x16* o, int vb, bf16x8 pa0, bf16x8 pa1, bf16x8 pa2, bf16x8 pa3, f32x16& P) {
  pv_one_sm<0>(o[0], vb, pa0, pa1, pa2, pa3, P); pv_one_sm<1>(o[1], vb, pa0, pa1, pa2, pa3, P); pv_one_sm<2>(o[2], vb, pa0, pa1, pa2, pa3, P); pv_one_sm<3>(o[3], vb, pa0, pa1, pa2, pa3, P);
}
__device__ __forceinline__ void pv_d0(f32x16* o, int vb, bf16x8 pa0, bf16x8 pa1, bf16x8 pa2, bf16x8 pa3) {
  pv_one<0>(o[0], vb, pa0, pa1, pa2, pa3); pv_one<1>(o[1], vb, pa0, pa1, pa2, pa3); pv_one<2>(o[2], vb, pa0, pa1, pa2, pa3); pv_one<3>(o[3], vb, pa0, pa1, pa2, pa3);
}

template <int MODE, bool QPREP = false>
__device__ __forceinline__ void attn_unit(const bf16* __restrict__ Qb, long ldq, const bf16* __restrict__ Kh, const bf16* __restrict__ Vh, long ldk,
                                          bf16* Ob, long ldo, int NT, char* lds, int kpos0, int npos, const float* tab, float* lse_out, long lse_stride, const float* qgain = nullptr, int qs0 = 0) {
  int tid = threadIdx.x; asm volatile("" : "+v"(tid));
  const int wid = __builtin_amdgcn_readfirstlane(tid >> 6), lane = tid & 63, r32 = lane & 31, hi = lane >> 5;
  constexpr int KOFF = (MODE == 0) ? 0 : (int)(2 * SHM_V), VOFF = (MODE == 0) ? 65536 : 0, WSOFF = (MODE == 0) ? (131072 + 1024) : (int)(2 * SHM_V + 2 * SHM_K);
  bf16* V_lds = (bf16*)(lds + VOFF); bf16* K_lds = (bf16*)(lds + KOFF);
  float* ws = (float*)(lds + WSOFF) + wid * 64; float* li_l = ws; float* al_l = ws + 32;
  float m_reg = -1e30f, l_reg = 0; f32x16 o[4] = {}; bf16x8 qr[8];
  const bf16* Qw = Qb + (long)(wid * QBLK + r32) * ldq + hi * 8;
#pragma unroll
  for (int d0 = 0; d0 < 8; ++d0) qr[d0] = *reinterpret_cast<const bf16x8*>(Qw + d0 * 16);
  if constexpr (QPREP) {
    float x[8][8]; float ssq = 0.f;
#pragma unroll
    for (int d0 = 0; d0 < 8; ++d0)
#pragma unroll
      for (int j = 0; j < 8; ++j) { x[d0][j] = __builtin_bit_cast(float, (unsigned)(unsigned short)qr[d0][j] << 16); ssq += x[d0][j] * x[d0][j]; }
    { auto rr = __builtin_amdgcn_permlane32_swap(__float_as_uint(ssq), __float_as_uint(ssq), false, false); ssq = __uint_as_float(rr[0]) + __uint_as_float(rr[1]); }
    const float rstd = 1.0f / sqrtf(ssq * (1.0f / 128.0f) + 1e-6f);
    const int sq = qs0 + wid * QBLK + r32;
#pragma unroll
    for (int aa = 0; aa < 2; ++aa) { const float pos = (float)(aa == 0 ? (sq >> 6) : (sq & 63));
#pragma unroll
      for (int dd = 0; dd < 2; ++dd) { const int d0 = aa * 4 + dd;
#pragma unroll
        for (int j = 0; j < 8; ++j) { const int i = 16 * dd + 8 * hi + j; const int e1 = aa * 64 + i;
          const float rev = pos * exp2f(-(float)i * 0.41524101186092029f) * 0.15915494309189535f;
          const float sn = __builtin_amdgcn_sinf(rev), cs = __builtin_amdgcn_cosf(rev);
          const float y1 = x[d0][j] * rstd * qgain[e1], y2 = x[d0 + 2][j] * rstd * qgain[e1 + 32];
          x[d0][j] = y1 * cs - y2 * sn; x[d0 + 2][j] = y2 * cs + y1 * sn; } } }
#pragma unroll
    for (int d0 = 0; d0 < 8; ++d0) { u32x4 w = {cvtpk(x[d0][0], x[d0][1]), cvtpk(x[d0][2], x[d0][3]), cvtpk(x[d0][4], x[d0][5]), cvtpk(x[d0][6], x[d0][7])}; qr[d0] = *reinterpret_cast<bf16x8*>(&w); }
  }
  const int sr = tid >> 4, sc = (tid & 15) * 8, vst0 = v_st(sr, sc), vst1 = vst0 + 8192;
  const int vb0 = (int)(uintptr_t)V_lds + v_rd_base(lane);
  const int qrel = wid * QBLK + r32;
  constexpr int SD = (MODE == 0) ? ATT_SD0 : 2;
  struct { bf16x8 vs0, vs1, ks0, ks1; } sr_[SD];
  const unsigned soff0 = (unsigned)(sr * (int)ldk + sc) * 2u, soff1 = soff0 + (unsigned)(32 * (int)ldk) * 2u;
#define KPOS(j) ((MODE == 1) ? ((kpos0 + (j) * KVBLK >= 0 && kpos0 + (j) * KVBLK < npos) ? (kpos0 + (j) * KVBLK) : 0) : ((j) * KVBLK))
#define SLOAD(i, j) do { const size_t kb_ = (size_t)KPOS(j) * (size_t)ldk * 2; const char* Kt_ = (const char*)Kh + kb_; const char* Vt_ = (const char*)Vh + kb_; \
    sr_[i].vs0 = *reinterpret_cast<const bf16x8*>(Vt_ + soff0); sr_[i].vs1 = *reinterpret_cast<const bf16x8*>(Vt_ + soff1); \
    sr_[i].ks0 = *reinterpret_cast<const bf16x8*>(Kt_ + soff0); sr_[i].ks1 = *reinterpret_cast<const bf16x8*>(Kt_ + soff1); } while (0)
#define SWRITE(b, i) do { *(bf16x8*)((char*)V_lds + (b) * SHM_V + vst0) = sr_[i].vs0;          \
    *(bf16x8*)((char*)V_lds + (b) * SHM_V + vst1) = sr_[i].vs1; int kc = sc * 2;               \
    *(bf16x8*)((char*)K_lds + (b) * SHM_K + KSWZ(sr, kc)) = sr_[i].ks0;                       \
    *(bf16x8*)((char*)K_lds + (b) * SHM_K + KSWZ(32 + sr, kc)) = sr_[i].ks1; } while (0)
#define SWAIT() do { if constexpr (SD == 2) asm volatile("s_waitcnt vmcnt(4)" ::: "memory"); else asm volatile("s_waitcnt vmcnt(0)" ::: "memory"); } while (0)
#define RESC(a) do { if (__any((a) < 1.f)) { if (hi == 0) al_l[r32] = (a); asm volatile("s_waitcnt lgkmcnt(0)" ::: "memory"); \
    _Pragma("unroll") for (int d = 0; d < 4; ++d) _Pragma("unroll") for (int r = 0; r < 16; ++r) o[d][r] *= al_l[crow(r, hi)]; } } while (0)
#define BIASM(P0, P1, j) do { if constexpr (MODE == 1) { const int kp_ = kpos0 + (j) * KVBLK; \
    if (kp_ >= 0 && kp_ < npos) { const float* tb_ = tab + ((j) * KVBLK - 64 + 4 * hi - qrel + TAB_PAD); \
      _Pragma("unroll") for (int r = 0; r < 16; ++r) { P0[r] += tb_[(r & 3) + 8 * (r >> 2)]; P1[r] += tb_[32 + (r & 3) + 8 * (r >> 2)]; } } \
    else { _Pragma("unroll") for (int r = 0; r < 16; ++r) { P0[r] = -INFINITY; P1[r] = -INFINITY; } } } } while (0)
  if constexpr (MODE == 1) {
    f32x16 pA0, pA1; float mnA, alA; bf16x8 pa0, pa1, pa2, pa3;
    const int jlo = wid >> 1;
    SLOAD(0, 0); SLOAD(1, 1);
    for (int j = 0; j < NT; j += 2) {
      SWRITE(0, 0); __syncthreads();
      if (j + 2 < NT) SLOAD(0, j + 2);
      if (j >= jlo && j <= jlo + 2) {
        qkt(pA0, pA1, K_lds, qr, r32, hi); BIASM(pA0, pA1, j); partialSM(pA0, pA1, m_reg, mnA, alA);
        RESC(alA);
        finishSM(pA0, pA1, alA, l_reg, pa0, pa1, pa2, pa3); SBAR();
        pv_d0(o, vb0, pa0, pa1, pa2, pa3);
      }
      SWRITE(1, 1); __syncthreads();
      if (j + 3 < NT) SLOAD(1, j + 3);
      if (j + 1 >= jlo && j + 1 <= jlo + 2) {
        qkt(pA0, pA1, (bf16*)((char*)K_lds + SHM_K), qr, r32, hi); BIASM(pA0, pA1, j + 1); partialSM(pA0, pA1, m_reg, mnA, alA);
        RESC(alA);
        finishSM(pA0, pA1, alA, l_reg, pa0, pa1, pa2, pa3); SBAR();
        pv_d0(o, vb0 + (int)SHM_V, pa0, pa1, pa2, pa3);
      }
    }
  } else {
  f32x16 pA0, pA1, pB0, pB1; float mnA, mnB, alA, alB; bf16x8 pa0, pa1, pa2, pa3;
  bf16x8 pv0_, pv1_, pv2_, pv3_, pk0_, pk1_, pk2_, pk3_;
  const int NP = NT >> 1;
  const unsigned rstep = (unsigned)(32 * (int)ldk) * 2u;
#define PLOADK(pp) do { const size_t kb_ = (size_t)(pp) * 128 * (size_t)ldk * 2; const char* Kt_ = (const char*)Kh + kb_ + soff0; \
    pk0_ = *reinterpret_cast<const bf16x8*>(Kt_); pk1_ = *reinterpret_cast<const bf16x8*>(Kt_ + rstep); pk2_ = *reinterpret_cast<const bf16x8*>(Kt_ + 2 * rstep); pk3_ = *reinterpret_cast<const bf16x8*>(Kt_ + 3 * rstep); } while (0)
#define PLOADV(pp) do { const size_t kb_ = (size_t)(pp) * 128 * (size_t)ldk * 2; const char* Vt_ = (const char*)Vh + kb_ + soff0; \
    pv0_ = *reinterpret_cast<const bf16x8*>(Vt_); pv1_ = *reinterpret_cast<const bf16x8*>(Vt_ + rstep); pv2_ = *reinterpret_cast<const bf16x8*>(Vt_ + 2 * rstep); pv3_ = *reinterpret_cast<const bf16x8*>(Vt_ + 3 * rstep); } while (0)
#define PLOAD(pp) do { PLOADK(pp); PLOADV(pp); } while (0)
#define PWRITE(c) do { const int kc = sc * 2; char* vb_ = (char*)V_lds + (c) * 32768; char* kb2_ = (char*)K_lds + (c) * 32768; \
    *(bf16x8*)(vb_ + vst0) = pv0_; *(bf16x8*)(vb_ + vst1) = pv1_; *(bf16x8*)(vb_ + 16384 + vst0) = pv2_; *(bf16x8*)(vb_ + 16384 + vst1) = pv3_; \
    *(bf16x8*)(kb2_ + KSWZ(sr, kc)) = pk0_; *(bf16x8*)(kb2_ + KSWZ(32 + sr, kc)) = pk1_; *(bf16x8*)(kb2_ + 16384 + KSWZ(sr, kc)) = pk2_; *(bf16x8*)(kb2_ + 16384 + KSWZ(32 + sr, kc)) = pk3_; } while (0)
#define KSUB(c, sb) ((bf16*)((char*)K_lds + (c) * 32768 + (sb) * 16384))
#define VSUB(c, sb) (vb0 + (c) * 32768 + (sb) * 16384)
  PLOAD(0); asm volatile("s_waitcnt vmcnt(0)" ::: "memory"); PWRITE(0); __syncthreads();
  qkt(pA0, pA1, KSUB(0, 0), qr, r32, hi); partialSM(pA0, pA1, m_reg, mnA, alA);
#define PAIR_FULL(c, oc, NEXTP) do { \
    SBAR(); PLOADK(NEXTP); qkt(pB0, pB1, KSUB(c, 1), qr, r32, hi); \
    finishSM(pA0, pA1, alA, l_reg, pa0, pa1, pa2, pa3); SBAR(); \
    PLOADV(NEXTP); \
    partialSM_pre(pB0, pB1, m_reg, mnB, alB); pv_d0_sm(o, VSUB(c, 0), pa0, pa1, pa2, pa3, pB0); \
    RESC(alB); \
    PWRITE(oc); \
    __syncthreads(); \
    SBAR(); qkt(pA0, pA1, KSUB(oc, 0), qr, r32, hi); \
    finishSM(pB0, pB1, alB, l_reg, pa0, pa1, pa2, pa3); SBAR(); \
    partialSM_pre(pA0, pA1, m_reg, mnA, alA); pv_d0_sm(o, VSUB(c, 1), pa0, pa1, pa2, pa3, pA0); \
    RESC(alA); \
    __syncthreads(); } while (0)
  for (int p = 0; p + 2 < NP; p += 2) {
    PAIR_FULL(0, 1, p + 1);
    PAIR_FULL(1, 0, p + 2);
  }
  PAIR_FULL(0, 1, NP - 1);
  { SBAR(); qkt(pB0, pB1, KSUB(1, 1), qr, r32, hi);
    finishSM(pA0, pA1, alA, l_reg, pa0, pa1, pa2, pa3); SBAR();
    partialSM_pre(pB0, pB1, m_reg, mnB, alB); pv_d0_sm(o, VSUB(1, 0), pa0, pa1, pa2, pa3, pB0);
    RESC(alB);
    finishSM(pB0, pB1, alB, l_reg, pa0, pa1, pa2, pa3); SBAR();
    pv_d0(o, VSUB(1, 1), pa0, pa1, pa2, pa3); }
#undef PAIR_FULL
#undef PLOAD
#undef PLOADK
#undef PLOADV
#undef PWRITE
#undef KSUB
#undef VSUB
  }
  if (hi == 0) li_l[r32] = l_reg; asm volatile("s_waitcnt lgkmcnt(0)" ::: "memory");
  if constexpr (MODE == 1) { if (hi == 0) lse_out[(long)(wid * QBLK + r32) * lse_stride] = m_reg * SCALE + __logf(l_reg); }
  float rli[16];
#pragma unroll
  for (int r = 0; r < 16; ++r) rli[r] = __builtin_amdgcn_rcpf(li_l[crow(r, hi)]);
  bf16* Ow = Ob + (long)(wid * QBLK) * ldo;
#pragma unroll
  for (int r = 0; r < 16; ++r) { const int orow = crow(r, hi);
#pragma unroll
    for (int d0 = 0; d0 < 4; ++d0) Ow[(long)orow * ldo + d0 * 32 + r32] = __float2bfloat16(o[d0][r] * rli[r]); }
  __syncthreads();
#undef KPOS
#undef SLOAD
#undef SWRITE
#undef SWAIT
#undef RESC
#undef BIASM
}
#undef SBAR
}

constexpr int NWAVES = 8;
constexpr int DM = 2048, BATCH = 2, SEQ = 16384, MTOK = BATCH * SEQ, DFF = 5632, INW = 10752, MEMT = 256, MEMW = 512;
constexpr int O_QA = 0, O_KA = 1024, O_VA = 1280, O_QB = 1536, O_KB = 4608, O_VB = 7680;
constexpr float EPS = 1e-6f;
constexpr size_t MiB = 1u << 20;
constexpr size_t WS_WGU1 = 1 * MiB, WS_WD1 = WS_WGU1 + 44 * MiB, WS_WGU2 = WS_WD1 + 22 * MiB, WS_WD2 = WS_WGU2 + 44 * MiB, WS_WIN = WS_WD2 + 22 * MiB,
                 WS_WOUT = WS_WIN + 42 * MiB, WS_WQM = WS_WOUT + 8 * MiB, WS_WKVM = WS_WQM + 2 * MiB, WS_WOM = WS_WKVM + 4 * MiB, WS_HM = WS_WOM + 2 * MiB,
                 WS_KVM = WS_HM + 2 * MiB, WS_LSE = WS_KVM + 1 * MiB, WS_H = 200 * MiB, WS_PROJ = 328 * MiB, WS_END = 1000 * MiB;
static_assert(WS_LSE + 3 * MiB <= WS_H, "ws map");
constexpr size_t WS_ACT = WS_PROJ, WS_QM = WS_PROJ, WS_OM = WS_PROJ + 32 * MiB;
constexpr int RING_BYTES = 131072, LDS_BYTES = 131072 + 1024 + 2048;
constexpr int NPH = 17;

typedef unsigned short bf16r;
typedef float f32x4 __attribute__((ext_vector_type(4)));
typedef unsigned v4u __attribute__((ext_vector_type(4)));
#define LAS __attribute__((address_space(3)))

__device__ __forceinline__ unsigned f2bf(float f) { unsigned u = __builtin_bit_cast(unsigned, f); return (u + 0x7fffu + ((u >> 16) & 1u)) >> 16; }
__device__ __forceinline__ unsigned pk2(float lo, float hi) { return f2bf(lo) | (f2bf(hi) << 16); }
__device__ __forceinline__ float bf2f(unsigned short b) { return __builtin_bit_cast(float, (unsigned)b << 16); }
__device__ __forceinline__ float wave_sum(float v) {
#pragma unroll
    for (int o = 1; o < 64; o <<= 1) v += __shfl_xor(v, o);
    return v;
}
__device__ __forceinline__ void transpose_item(const float* W, int K, int N, bf16r* WT, int k0, int n0, int drow0, LAS float* scr, int lane, const float* gain) {
    { const int kr = lane >> 3, nq = lane & 7; f32x4 v[8];
#pragma unroll
      for (int i = 0; i < 8; ++i) v[i] = *(const f32x4*)(W + (size_t)(k0 + 8 * i + kr) * N + n0 + 4 * nq);
      if (gain) {
#pragma unroll
        for (int i = 0; i < 8; ++i) v[i] = v[i] * gain[k0 + 8 * i + kr]; }
#pragma unroll
      for (int i = 0; i < 8; ++i) { LAS float* d = scr + (8 * i + kr) * 33 + 4 * nq; d[0] = v[i].x; d[1] = v[i].y; d[2] = v[i].z; d[3] = v[i].w; } }
    asm volatile("s_waitcnt lgkmcnt(0)" ::: "memory");
    const int c = lane & 7;
#pragma unroll
    for (int j = 0; j < 4; ++j) { const int n = (lane >> 3) + 8 * j; const LAS float* s = scr + (8 * c) * 33 + n;
        v4u o; o.x = pk2(s[0 * 33], s[1 * 33]); o.y = pk2(s[2 * 33], s[3 * 33]); o.z = pk2(s[4 * 33], s[5 * 33]); o.w = pk2(s[6 * 33], s[7 * 33]);
        *(v4u*)(WT + (size_t)(drow0 + n) * K + k0 + 8 * c) = o; }
    asm volatile("s_waitcnt lgkmcnt(0)" ::: "memory");
}
__device__ __forceinline__ void transpose_mat(const float* W, int K, int N, bf16r* WT, int mode, int item, LAS float* scr, int lane, const float* gain = nullptr) {
    const int nblk = N / 32, kb = item / nblk, nb = item % nblk, k0 = 64 * kb, n0 = 32 * nb;
    int drow0 = n0;
    if (mode != 0) drow0 = (n0 >> 7) * 256 + (n0 & 127) + (mode == 2 ? 128 : 0);
    transpose_item(W, K, N, WT, k0, n0, drow0, scr, lane, gain);
}
__device__ __forceinline__ void rms_row_bf16(const float* xrow, const float* g, bf16r* orow, int lane) {
    const f32x4* xr = (const f32x4*)xrow + lane; f32x4 v[8]; float s = 0.f;
#pragma unroll
    for (int j = 0; j < 8; ++j) { v[j] = xr[64 * j]; s += (v[j].x * v[j].x + v[j].y * v[j].y) + (v[j].z * v[j].z + v[j].w * v[j].w); }
    const float rstd = 1.0f / sqrtf(wave_sum(s) * (1.f / DM) + EPS);
    const f32x4* gr = (const f32x4*)g + lane; unsigned long long* o8 = (unsigned long long*)orow + lane;
#pragma unroll
    for (int j = 0; j < 8; ++j) { const f32x4 gv = gr[64 * j]; const f32x4 y = v[j] * rstd * gv;
        o8[64 * j] = (unsigned long long)pk2(y.x, y.y) | ((unsigned long long)pk2(y.z, y.w) << 32); }
}
__device__ __forceinline__ void rms_row_f32(float* xrow, const float* g, int lane) {
    f32x4* xr = (f32x4*)xrow + lane; f32x4 v[8]; float s = 0.f;
#pragma unroll
    for (int j = 0; j < 8; ++j) { v[j] = xr[64 * j]; s += (v[j].x * v[j].x + v[j].y * v[j].y) + (v[j].z * v[j].z + v[j].w * v[j].w); }
    const float rstd = 1.0f / sqrtf(wave_sum(s) * (1.f / DM) + EPS);
    const f32x4* gr = (const f32x4*)g + lane;
#pragma unroll
    for (int j = 0; j < 8; ++j) { const f32x4 gv = gr[64 * j]; xr[64 * j] = v[j] * rstd * gv; }
}
__device__ __forceinline__ int t5_bucket(int rel) {
    const int n = rel < 0 ? -rel : rel; int v;
    if (n < 8) v = n; else v = 8 + (n >= 15) + (n >= 27) + (n >= 50) + (n >= 91) + (n >= 166) + (n >= 305) + (n >= 559);
    return (rel > 0 ? 16 : 0) + v;
}


#define RLX_AGENT __ATOMIC_RELAXED, __HIP_MEMORY_SCOPE_AGENT
#define XB_TMO      128
#define XB_XCNT(j)  (256  + 64 * (j))
#define XB_XSUB(j)  (1280 + 64 * (j))
#define XB_XGEN(j)  (2304 + 64 * (j))
#define XB_TOP      3328
#define XB_TOPGEN   3392
#define XCD_BAR_WORDS 3456
#define XB_SPIN_CAP (1u << 22)

__device__ __forceinline__ unsigned xb_ld(unsigned* p)              { return __hip_atomic_load(p, __ATOMIC_RELAXED, __HIP_MEMORY_SCOPE_AGENT); }
__device__ __forceinline__ unsigned xb_add(unsigned* p, unsigned v) { return __hip_atomic_fetch_add(p, v, __ATOMIC_RELAXED, __HIP_MEMORY_SCOPE_AGENT); }
__device__ __forceinline__ unsigned xb_xcc_id() { return (unsigned)__builtin_amdgcn_s_getreg((3 << 11) | 20) & 0xFu; }
#define XB_SPIN(cond, bar) do { unsigned _sp = 0; while (cond) { __builtin_amdgcn_s_sleep(1); \
    if ((++_sp & 255u) == 0u) { if (xb_ld(&(bar)[XB_TMO])) break; if (_sp > XB_SPIN_CAP) { atomicAdd(&(bar)[XB_TMO], 1u); break; } } } } while (0)

struct XcdBarrier {
    unsigned* bar; unsigned x;
    volatile LAS unsigned* st;
};

__device__ __forceinline__ XcdBarrier xcd_barrier_post(unsigned* bar, volatile LAS unsigned* st) {
    XcdBarrier b; b.bar = bar; b.x = xb_xcc_id(); b.st = st;
    if (threadIdx.x == 0) (void)xb_add(&bar[XB_XCNT(b.x)], 1u);
    return b;
}
__device__ __forceinline__ void xcd_barrier_complete(unsigned* bar, unsigned x, unsigned& nloc, unsigned& nx) {
    const unsigned G = gridDim.x * gridDim.y * gridDim.z;
    unsigned sum, cnt, mine, sp = 0u;
    for (;;) {
        sum = 0u; cnt = 0u; mine = 0u;
#pragma unroll
        for (unsigned j = 0; j < 16; ++j) { const unsigned c = xb_ld(&bar[XB_XCNT(j)]); sum += c; cnt += (c > 0u) ? 1u : 0u; mine = (j == x) ? c : mine; }
        if (sum == G) break;
        __builtin_amdgcn_s_sleep(1);
        if ((++sp & 255u) == 0u) { if (xb_ld(&bar[XB_TMO])) break; if (sp > XB_SPIN_CAP) { atomicAdd(&bar[XB_TMO], 1u); break; } }
    }
    nloc = mine > 0u ? mine : 1u; nx = cnt > 0u ? cnt : 1u;
}

__device__ __forceinline__ void xcd_barrier(const XcdBarrier& b) {
    asm volatile("s_waitcnt vmcnt(0)" ::: "memory");
    __syncthreads();
    if (threadIdx.x == 0) {
        unsigned* bar = b.bar;
        __builtin_amdgcn_s_waitcnt(0);
        unsigned nloc = b.st[0], nx = b.st[1];
        if (nloc == 0u) { xcd_barrier_complete(bar, b.x, nloc, nx); b.st[0] = nloc; b.st[1] = nx; }
        const unsigned old = xb_add(&bar[XB_XSUB(b.x)], 1u);
        const unsigned gen = old / nloc;
        if (old + 1u == (gen + 1u) * nloc) {
            __builtin_amdgcn_fence(__ATOMIC_RELEASE, "agent");
            asm volatile("s_waitcnt vmcnt(0)" ::: "memory");
            const unsigned og = xb_add(&bar[XB_TOP], 1u);
            const unsigned tg = og / nx;
            if (og + 1u == (tg + 1u) * nx) xb_add(&bar[XB_TOPGEN], 1u);
            else XB_SPIN(xb_ld(&bar[XB_TOPGEN]) == tg, bar);
            __builtin_amdgcn_fence(__ATOMIC_ACQUIRE, "agent");
            xb_add(&bar[XB_XGEN(b.x)], 1u);
            asm volatile("s_waitcnt vmcnt(0)" ::: "memory");
        } else {
            XB_SPIN(xb_ld(&bar[XB_XGEN(b.x)]) == gen, bar);
            __builtin_amdgcn_fence(__ATOMIC_ACQUIRE, "agent");
            asm volatile("s_waitcnt vmcnt(0)" ::: "memory");
        }
    }
    __syncthreads();
}

struct Args { const float* in[22]; float* out; unsigned char* ws; int ph_lo, ph_hi; };
enum { I_X = 0, I_MEM, I_F1N, I_F1G, I_F1U, I_F1D, I_MIXN, I_WIN, I_QN, I_KN, I_RELB, I_WOUT, I_MXN, I_MMN, I_WQM, I_WKVM, I_WOM, I_F2N, I_F2G, I_F2U, I_F2D, I_FIN };

__global__ void __launch_bounds__(NWAVES * 64, 2) mk_fwd(Args args) {
    extern __shared__ __attribute__((aligned(16))) unsigned char lds[];
    LAS unsigned char* ldsl = (LAS unsigned char*)lds;
    const int tid = threadIdx.x, lane = tid & 63, wave = __builtin_amdgcn_readfirstlane(tid >> 6);
    const int G = gridDim.x, bx = blockIdx.x;
    const int vcu = (G % 8 == 0) ? (bx % 8) * (G / 8) + bx / 8 : bx;
    const int gw = vcu * NWAVES + wave, NGW = G * NWAVES;
    unsigned char* ws = args.ws;
    float* out = args.out;
#define WGU1 ((bf16r*)(ws + WS_WGU1))
#define WD1 ((bf16r*)(ws + WS_WD1))
#define WGU2 ((bf16r*)(ws + WS_WGU2))
#define WD2 ((bf16r*)(ws + WS_WD2))
#define WIN ((bf16r*)(ws + WS_WIN))
#define WOUT ((bf16r*)(ws + WS_WOUT))
#define WQM ((bf16r*)(ws + WS_WQM))
#define WKVM ((bf16r*)(ws + WS_WKVM))
#define WOM ((bf16r*)(ws + WS_WOM))
#define HM ((bf16r*)(ws + WS_HM))
#define KVM ((bf16r*)(ws + WS_KVM))
#define LSE ((float*)(ws + WS_LSE))
#define H ((bf16r*)(ws + WS_H))
#define PROJ ((bf16r*)(ws + WS_PROJ))
#define ACT ((bf16r*)(ws + WS_ACT))
#define QM ((bf16r*)(ws + WS_QM))
#define OM ((bf16r*)(ws + WS_OM))
#define MIX ((bf16r*)out)
#define PCNT ((unsigned*)(ws + 32768))
#define SS ((float*)(ws + 65536))
#define XB2 ((bf16r*)(ws + WS_PROJ + 64 * MiB))
    const int lo = args.ph_lo, hi = args.ph_hi;
#ifndef PH_MASK
#define PH_MASK 0x1ffff
#endif
#define IN(k) (((PH_MASK >> (k)) & 1) && lo <= (k) && (k) < hi)
    volatile LAS unsigned* MISC = (volatile LAS unsigned*)(ldsl + RING_BYTES);
    if (tid < 16) MISC[tid] = 0u;
    __syncthreads();
    unsigned* barw = (unsigned*)ws;
    XcdBarrier xb; xb.bar = barw; xb.x = 0; xb.st = MISC;
#define SEAM(k) do { if (IN(k) && IN((k) + 1) && MK_N_LAUNCHES == 1) { if ((k) == 0) { cg::this_grid().sync(); xb = xcd_barrier_post(barw, MISC); } else { xcd_barrier(xb); } } } while (0)

    if (IN(0)) {
        if (bx == 0) { for (int t = tid; t < XCD_BAR_WORDS; t += NWAVES * 64) barw[t] = 0u; }
        LAS float* scr = (LAS float*)(ldsl + wave * 16384);
        constexpr int I_FG = (DM / 64) * (DFF / 32), I_FD = (DFF / 64) * (DM / 32), I_IN = (DM / 64) * (INW / 32), I_OUT = (DM / 64) * (DM / 32),
                      I_QM = (DM / 64) * (MEMW / 32), I_KVM = (DM / 64) * (2 * MEMW / 32), I_OM = (MEMW / 64) * (DM / 32);
        constexpr int NITEMS = 4 * I_FG + 2 * I_FD + I_IN + I_OUT + I_QM + I_KVM + I_OM;
        for (int it = gw; it < NITEMS; it += NGW) {
            int r = it;
            if (r < I_FG) { transpose_mat(args.in[I_F1G], DM, DFF, WGU1, 1, r, scr, lane); continue; } r -= I_FG;
            if (r < I_FG) { transpose_mat(args.in[I_F1U], DM, DFF, WGU1, 2, r, scr, lane); continue; } r -= I_FG;
            if (r < I_FD) { transpose_mat(args.in[I_F1D], DFF, DM, WD1, 0, r, scr, lane); continue; } r -= I_FD;
            if (r < I_IN) { transpose_mat(args.in[I_WIN], DM, INW, WIN, 0, r, scr, lane, args.in[I_MIXN]); continue; } r -= I_IN;
            if (r < I_OUT) { transpose_mat(args.in[I_WOUT], DM, DM, WOUT, 0, r, scr, lane); continue; } r -= I_OUT;
            if (r < I_QM) { transpose_mat(args.in[I_WQM], DM, MEMW, WQM, 0, r, scr, lane, args.in[I_MXN]); continue; } r -= I_QM;
            if (r < I_KVM) { transpose_mat(args.in[I_WKVM], DM, 2 * MEMW, WKVM, 0, r, scr, lane); continue; } r -= I_KVM;
            if (r < I_OM) { transpose_mat(args.in[I_WOM], MEMW, DM, WOM, 0, r, scr, lane); continue; } r -= I_OM;
            if (r < I_FG) { transpose_mat(args.in[I_F2G], DM, DFF, WGU2, 1, r, scr, lane, args.in[I_F2N]); continue; } r -= I_FG;
            if (r < I_FG) { transpose_mat(args.in[I_F2U], DM, DFF, WGU2, 2, r, scr, lane, args.in[I_F2N]); continue; } r -= I_FG;
            transpose_mat(args.in[I_F2D], DFF, DM, WD2, 0, r, scr, lane);
        }
        for (int i = gw * 64 + lane; i < 4 * MTOK; i += NGW * 64) SS[i] = 0.f;
        for (int i = gw * 64 + lane; i < 128 * 64; i += NGW * 64) PCNT[i] = 0u;
        for (int m = gw; m < MTOK; m += NGW) rms_row_bf16(args.in[I_X] + (size_t)m * DM, args.in[I_F1N], H + (size_t)m * DM, lane);
        for (int m = gw; m < BATCH * MEMT; m += NGW) rms_row_bf16(args.in[I_MEM] + (size_t)m * DM, args.in[I_MMN], HM + (size_t)m * DM, lane);
        __syncthreads();
    }
    SEAM(0);
    if (IN(1)) {
        { pg8::Gemm g{H, WGU1, MTOK, 2 * DFF, DM}; pg8::StaticOrder S; S.init(MTOK, 2 * DFF, G, bx);
          pg8::EpiSwiGLU<false> E{ACT, DFF, nullptr};
          pg8::gemm_phase<pg8::EpiSwiGLU<false>, pg8::StaticOrder, true, true>(ldsl, g, S, E); }
        { pg8::Gemm g{HM, WKVM, BATCH * MEMT, 2 * MEMW, DM}; pg8::StaticOrder S; S.init(BATCH * MEMT, 2 * MEMW, G, bx);
          pg8::EpiBf16<false> E{KVM, 2 * MEMW, nullptr};
          pg8::gemm_phase<pg8::EpiBf16<false>, pg8::StaticOrder, true, true>(ldsl, g, S, E); }
    }
    SEAM(1);
    if (IN(2)) {
        pg8::Gemm g{ACT, WD1, MTOK, DM, DFF}; pg8::StaticOrder S; S.init(MTOK, DM, G, bx, 4);
        pg8::EpiRes<false, false, true> E{args.in[I_X], nullptr, nullptr, H, SS, DM, 0.5f};
        pg8::gemm_phase<pg8::EpiRes<false, false, true>, pg8::StaticOrder, true, true>(ldsl, g, S, E);
    }
    SEAM(2);
    if (IN(4)) {
        pg8::Gemm g{H, WIN, MTOK, INW, DM}; pg8::StaticOrder S; S.init(MTOK, INW, G, bx);
        pg8::EpiBf16<true> E{PROJ, INW, SS};
        pg8::gemm_phase<pg8::EpiBf16<true>, pg8::StaticOrder, true, true>(ldsl, g, S, E);
    }
    SEAM(4);
    if (IN(5)) {
        const int hh = lane >> 5, a = (lane >> 4) & 1, i = (lane & 15) * 2;
        const float invf0 = exp2f(-(float)i * 0.41524101186092029f), invf1 = exp2f(-(float)(i + 1) * 0.41524101186092029f);
        const float* qn = args.in[I_QN] + a * 64 + i; const float* kn = args.in[I_KN] + a * 64 + i;
        const float gq1a = qn[0], gq1b = qn[1], gq2a = qn[32], gq2b = qn[33], gk1a = kn[0], gk1b = kn[1], gk2a = kn[32], gk2b = kn[33];
        for (int row = gw; row < MTOK; row += NGW) {
            const int s = row & (SEQ - 1);
            const float pos = (float)(a == 0 ? (s >> 6) : (s & 63));
            const float rev0 = pos * invf0 * 0.15915494309189535f, rev1 = pos * invf1 * 0.15915494309189535f;
            const float sn0 = __builtin_amdgcn_sinf(rev0), cs0 = __builtin_amdgcn_cosf(rev0), sn1 = __builtin_amdgcn_sinf(rev1), cs1 = __builtin_amdgcn_cosf(rev1);
            unsigned* prow = (unsigned*)(PROJ + (size_t)row * INW + a * 64 + i);
#pragma unroll
            for (int it = 4; it < 5; ++it) {
                unsigned* p = prow + (it * 2 + hh) * 64;
                const unsigned u1 = p[0], u2 = p[16];
                const float x1a = __builtin_bit_cast(float, u1 << 16), x1b = __builtin_bit_cast(float, u1 & 0xffff0000u);
                const float x2a = __builtin_bit_cast(float, u2 << 16), x2b = __builtin_bit_cast(float, u2 & 0xffff0000u);
                float ss = (x1a * x1a + x1b * x1b) + (x2a * x2a + x2b * x2b);
#pragma unroll
                for (int o = 1; o < 32; o <<= 1) ss += __shfl_xor(ss, o);
                const float rstd = 1.0f / sqrtf(ss * (1.f / 128.f) + EPS);
                const bool isq = it < 4;
                const float y1a = x1a * rstd * (isq ? gq1a : gk1a), y1b = x1b * rstd * (isq ? gq1b : gk1b);
                const float y2a = x2a * rstd * (isq ? gq2a : gk2a), y2b = x2b * rstd * (isq ? gq2b : gk2b);
                p[0] = pk2(y1a * cs0 - y2a * sn0, y1b * cs1 - y2b * sn1);
                p[16] = pk2(y2a * cs0 + y1a * sn0, y2b * cs1 + y1b * sn1);
            }
        }
    }
    SEAM(5);
    if (IN(6)) {
        const att::bf16* P = (const att::bf16*)PROJ;
        int u0, ustep, uend;
        if (G % 8 == 0) { const int per = G / 8, x = vcu / per, j = vcu % per; u0 = x * 128 + j; ustep = per; uend = x * 128 + 128; }
        else { u0 = bx; ustep = G; uend = 1024; }
        float* tab = (float*)((char*)lds + att::SHM_ATTN);
        const int bper = (3072 + G - 1) / G; int gh_prev = -1;
        const int bu0 = vcu * bper, bu1 = (bu0 + bper < 3072) ? bu0 + bper : 3072;
        const int nA = (uend > u0) ? (uend - u0 + ustep - 1) / ustep : 0;
        const int bchunk = (nA > 0) ? (bper + nA - 1) / nA : bper;
        const int nBc = (bu1 > bu0) ? (bu1 - bu0 + bchunk - 1) / bchunk : 0;
        const int nsteps = 2 * (nA > nBc ? nA : nBc), par = vcu & 1;
        for (int step = 0; step < nsteps; ++step) {
            const int k = step >> 1;
            if (((step + par) & 1) == 0) {
                const int u = u0 + k * ustep;
                if (k < nA && u < uend) {
                    const int combo = u >> 8, b = combo >> 1, kvh = combo & 1, hq = kvh * 4 + ((u >> 6) & 3), qb = u & 63;
                    const size_t rowq = (size_t)b * SEQ + (size_t)qb * 256;
                    att::attn_unit<0, true>(P + rowq * INW + O_QA + hq * 128, INW, P + (size_t)b * SEQ * INW + O_KA + kvh * 128, P + (size_t)b * SEQ * INW + O_VA + kvh * 128, INW,
                                      (att::bf16*)MIX + rowq * DM + hq * 128, DM, SEQ / 64, (char*)lds, 0, 0, nullptr, nullptr, 0, args.in[I_QN], qb * 256);
                    gh_prev = -1;
                }
            } else {
                for (int u = bu0 + k * bchunk; u < bu1 && u < bu0 + (k + 1) * bchunk; ++u) {
                    const int g = u >> 10, b = (u >> 9) & 1, h = (u >> 6) & 7, idx = u & 63;
                    const int r = (g == 0) ? 1 : (g == 1 ? 4 : 16), npos = SEQ / r, nblk = npos / 256, c = idx / nblk, qb = idx % nblk, a0 = qb * 256;
                    if ((g * 8 + h) != gh_prev) { gh_prev = g * 8 + h;
                    for (int t = tid; t < att::TAB_N; t += NWAVES * 64) { const int d = t - att::TAB_PAD;
                        tab[t] = (d >= -64 && d <= 64) ? args.in[I_RELB][t5_bucket(r * d) * 24 + g * 8 + h] * (1.0f / att::SCALE) : -INFINITY; } }
                    const size_t row0 = (size_t)b * SEQ + c;
                    const long ld = (long)r * INW;
                    att::bf16* Pq = (att::bf16*)PROJ + row0 * INW + O_QB + g * 1024 + h * 128;
                    const att::bf16* Pk = P + row0 * INW + O_KB + g * 1024 + h * 128;
                    const att::bf16* Pv = P + row0 * INW + O_VB + g * 1024 + h * 128;
                    float* lse = LSE + ((size_t)g * MTOK + row0 + (size_t)a0 * r) * 8 + h;
                    att::attn_unit<1>(Pq + (long)a0 * ld, ld, Pk, Pv, ld, Pq + (long)a0 * ld, ld, 6, (char*)lds, a0 - 64, npos, tab, lse, (long)r * 8);
                }
            }
        }
    }
    SEAM(6);
    if (IN(7)) {
        for (int m = gw; m < MTOK; m += NGW) {
#pragma unroll
            for (int j = 0; j < 2; ++j) {
                const int e = j * 512 + lane * 8, h = e >> 7;
                const float l0 = LSE[((size_t)0 * MTOK + m) * 8 + h], l1 = LSE[((size_t)1 * MTOK + m) * 8 + h], l2 = LSE[((size_t)2 * MTOK + m) * 8 + h];
                const float mx = fmaxf(l0, fmaxf(l1, l2)); float w0 = __expf(l0 - mx), w1 = __expf(l1 - mx), w2 = __expf(l2 - mx);
                const float inv = 1.0f / (w0 + w1 + w2); w0 *= inv; w1 *= inv; w2 *= inv;
                const bf16r* p = PROJ + (size_t)m * INW + O_QB + e;
                const v4u a0 = *(const v4u*)p, a1 = *(const v4u*)(p + 1024), a2 = *(const v4u*)(p + 2048);
                v4u o;
#pragma unroll
                for (int q = 0; q < 4; ++q) {
                    const float x0 = __builtin_bit_cast(float, a0[q] << 16), y0 = __builtin_bit_cast(float, a0[q] & 0xffff0000u);
                    const float x1 = __builtin_bit_cast(float, a1[q] << 16), y1 = __builtin_bit_cast(float, a1[q] & 0xffff0000u);
                    const float x2 = __builtin_bit_cast(float, a2[q] << 16), y2 = __builtin_bit_cast(float, a2[q] & 0xffff0000u);
                    o[q] = pk2(w0 * x0 + w1 * x1 + w2 * x2, w0 * y0 + w1 * y1 + w2 * y2);
                }
                *(v4u*)(MIX + (size_t)m * DM + 1024 + e) = o;
            }
        }
    }
    SEAM(7);
    if (IN(8)) {
        pg8::Gemm g{MIX, WOUT, MTOK, DM, DM}; pg8::StaticOrder S; S.init(MTOK, DM, G, bx, 4);
        pg8::EpiRes<true, false, true> E{nullptr, H, nullptr, XB2, SS + MTOK, DM, 1.0f};
        pg8::gemm_phase<pg8::EpiRes<true, false, true>, pg8::StaticOrder, true, true>(ldsl, g, S, E);
    }
    SEAM(8);
    if (IN(10)) {
        pg8::Gemm g{XB2, WQM, MTOK, MEMW, DM}; pg8::StaticOrder S; S.init(MTOK, MEMW, G, bx);
        pg8::EpiBf16<true> E{QM, MEMW, SS + MTOK};
        pg8::gemm_phase<pg8::EpiBf16<true>, pg8::StaticOrder, true, true>(ldsl, g, S, E);
    }
    SEAM(10);
    if (IN(11)) {
        for (int u = vcu; u < 512; u += G) {
            const int qb = u >> 2, h = u & 3; const size_t rowq = (size_t)qb * 256; const int b = (int)(rowq / SEQ);
            const att::bf16* kv = (const att::bf16*)KVM + (size_t)b * MEMT * (2 * MEMW);
            att::attn_unit<0>((const att::bf16*)QM + rowq * MEMW + h * 128, MEMW, kv + h * 128, kv + MEMW + h * 128, 2 * MEMW,
                              (att::bf16*)OM + rowq * MEMW + h * 128, MEMW, MEMT / 64, (char*)lds, 0, 0, nullptr, nullptr, 0);
        }
    }
    SEAM(11);
    if (IN(12)) {
        pg8::Gemm g{OM, WOM, MTOK, DM, MEMW}; pg8::StaticOrder S; S.init(MTOK, DM, G, bx, 4);
        pg8::EpiRes<true, false, true> E{nullptr, XB2, nullptr, H, SS + 2 * MTOK, DM, 1.0f};
        pg8::gemm_phase<pg8::EpiRes<true, false, true>, pg8::StaticOrder, true, true>(ldsl, g, S, E);
    }
    SEAM(12);
    if (IN(14)) {
        pg8::Gemm g{H, WGU2, MTOK, 2 * DFF, DM}; pg8::StaticOrder S; S.init(MTOK, 2 * DFF, G, bx);
        pg8::EpiSwiGLU<true> E{ACT, DFF, SS + 2 * MTOK};
        pg8::gemm_phase<pg8::EpiSwiGLU<true>, pg8::StaticOrder, true, true>(ldsl, g, S, E);
    }
    SEAM(14);
    if (IN(15)) {
        pg8::Gemm g{ACT, WD2, MTOK, DM, DFF}; pg8::StaticOrder S; S.init(MTOK, DM, G, bx, 4);
        pg8::EpiFinal E{H, out, SS + 3 * MTOK, PCNT, args.in[I_FIN], DM, 0.5f, (unsigned)(DM / 256)};
        pg8::gemm_phase<pg8::EpiFinal, pg8::StaticOrder, true, true>(ldsl, g, S, E);
    }
#undef IN
#undef SEAM
}

extern "C" void kernel_launch(void* const* d_in, const int* in_sizes, int n_in, void* d_out, int out_size, void* d_ws, size_t ws_size, hipStream_t stream) {
    static int grid = 0;
    if (grid == 0) {
        if (n_in != 22 || in_sizes[0] != MTOK * DM || out_size != MTOK * DM || ws_size < WS_END) {
            fprintf(stderr, "kernel_launch: unexpected shapes: n_in %d in0 %d out %d ws %zu (need >= %zu)\n", n_in, n_in > 0 ? in_sizes[0] : -1, out_size, ws_size, (size_t)WS_END); grid = -1; return; }
        int dev = 0, cus = 0, per_cu = 0;
        if (hipGetDevice(&dev) != hipSuccess || hipDeviceGetAttribute(&cus, hipDeviceAttributeMultiprocessorCount, dev) != hipSuccess) { fprintf(stderr, "kernel_launch: device query failed\n"); grid = -1; return; }
        if (hipFuncSetAttribute((const void*)mk_fwd, hipFuncAttributeMaxDynamicSharedMemorySize, LDS_BYTES) != hipSuccess) { fprintf(stderr, "kernel_launch: hipFuncSetAttribute failed\n"); grid = -1; return; }
        if (hipOccupancyMaxActiveBlocksPerMultiprocessor(&per_cu, (const void*)mk_fwd, NWAVES * 64, LDS_BYTES) != hipSuccess || per_cu < 1) { fprintf(stderr, "kernel_launch: occupancy query gave %d\n", per_cu); per_cu = 1; }
        (void)hipGetLastError();
        grid = cus * 1;
        fprintf(stderr, "kernel_launch: grid %d (cus %d, per_cu %d)\n", grid, cus, per_cu);
    }
    if (grid < 0) return;
    Args a{};
    for (int i = 0; i < 22; ++i) a.in[i] = (const float*)d_in[i];
    a.out = (float*)d_out; a.ws = (unsigned char*)d_ws;
    if (MK_N_LAUNCHES == 1) {
        a.ph_lo = 0; a.ph_hi = NPH;
        void* kargs[] = {&a};
        hipError_t e = hipLaunchCooperativeKernel((const void*)mk_fwd, dim3(grid), dim3(NWAVES * 64), kargs, LDS_BYTES, stream);
        if (e != hipSuccess) fprintf(stderr, "kernel_launch: cooperative launch failed: %s (grid %d)\n", hipGetErrorString(e), grid);
    } else {
        for (int p = 0; p < NPH; ++p) {
            a.ph_lo = p; a.ph_hi = p + 1;
            hipLaunchKernelGGL(mk_fwd, dim3(grid), dim3(NWAVES * 64), LDS_BYTES, stream, a);
        }
        hipError_t e = hipPeekAtLastError();
        if (e != hipSuccess) fprintf(stderr, "kernel_launch: launch failed: %s\n", hipGetErrorName(e));
    }
}
```

```cpp
#include <hip/hip_runtime.h>
#include <hip/hip_bf16.h>
#include <hip/hip_cooperative_groups.h>
#include <cstdio>
#include <cstdint>
#include <cmath>
namespace cg = cooperative_groups;

#ifndef ATT_SD0
#define ATT_SD0 2
#endif
#ifndef MK_N_LAUNCHES
#define MK_N_LAUNCHES 1
#endif

namespace pg8 {
#define PG8_LAS __attribute__((address_space(3)))
typedef unsigned short bf16_t;
typedef short bf16x8 __attribute__((ext_vector_type(8)));
typedef float f32x4 __attribute__((ext_vector_type(4)));
typedef unsigned u32x4 __attribute__((ext_vector_type(4)));
constexpr int BM = 256, BK = 64, HALF = 128, HTB = HALF * BK * 2, STAGE_BYTES = 8 * HTB, NXCD = 8, WGM = 8;

__host__ __device__ __forceinline__ int lds_byte(int r, int c) { const int st = (r >> 4) * 2 + (c >> 5), rr = r & 15, cc = c & 31, ob = rr * 64 + cc * 2; return st * 1024 + (ob ^ (((ob >> 9) & 1) << 5)); }
__host__ __device__ __forceinline__ void stage_rc(int b, int& R, int& C) { const int st = b / 1024, sb = b % 1024, swz = sb ^ (((sb >> 9) & 1) << 5); R = (st >> 1) * 16 + swz / 64; C = (st & 1) * 32 + (swz % 64) / 2; }
__host__ __device__ __forceinline__ int perm32(int rho) { const int n = rho >> 4, i = rho & 15; return 8 * (i >> 2) + 4 * n + (i & 3); }

struct Unit { int pm, pn; };
struct Gemm { const bf16_t* A; const bf16_t* Bt; int M, N, K; };

struct StaticOrder {
    int nM, nN, nwg, G, c, wgm;
    __host__ __device__ void init(int M, int N, int G_, int c_, int wgm_ = WGM) { nM = M / BM; nN = N / BM; nwg = nM * nN; G = G_; c = c_; wgm = wgm_; }
    __host__ __device__ bool next(int i, Unit& u) const {
        const long L = (long)i * G + c; if (L >= nwg) return false;
        int wgid = (int)L; { const int q = nwg / NXCD, r = nwg % NXCD, xcd = wgid % NXCD, off = wgid / NXCD; wgid = (xcd < r ? xcd * (q + 1) : r * (q + 1) + (xcd - r) * q) + off; }
        const int nig = wgm * nN, gid = wgid / nig, fm = gid * wgm, gsz = (nM - fm) < wgm ? (nM - fm) : wgm;
        u.pm = fm + ((wgid % nig) % gsz); u.pn = (wgid % nig) / gsz; return true;
    }
    __device__ __forceinline__ void a_ready(const Unit&) const {}
    __device__ __forceinline__ void done(const Unit&) const {}
};

__device__ __forceinline__ unsigned cvt_pk_bf16(float lo, float hi) { unsigned r; asm volatile("v_cvt_pk_bf16_f32 %0, %1, %2" : "=v"(r) : "v"(lo), "v"(hi)); return r; }

template <bool NORM> struct EpiBf16 {
    static constexpr bool PERM = true, AFTER_DRAIN = false;
    bf16_t* O; int ldc; const float* ss;
    __device__ __forceinline__ void operator()(const f32x4 (&acc)[2][2][4][2], const Unit& u, int wr, int wc, int fr, int fq) const {
        const int row0 = u.pm * BM + wr * 64 + fr; const int col0 = u.pn * BM + wc * 32 + 8 * fq;
#pragma unroll
        for (int ai = 0; ai < 2; ++ai)
#pragma unroll
            for (int m = 0; m < 4; ++m) { const int row = row0 + ai * HALF + m * 16; bf16_t* rowp = O + (size_t)row * ldc + col0;
                float rs = 1.0f; if constexpr (NORM) rs = 1.0f / sqrtf(ss[row] * (1.0f / 2048.0f) + 1e-6f);
#pragma unroll
                for (int bj = 0; bj < 2; ++bj) { const f32x4 v0 = acc[ai][bj][m][0] * rs, v1 = acc[ai][bj][m][1] * rs;
                    u32x4 w; w.x = cvt_pk_bf16(v0[0], v0[1]); w.y = cvt_pk_bf16(v0[2], v0[3]); w.z = cvt_pk_bf16(v1[0], v1[1]); w.w = cvt_pk_bf16(v1[2], v1[3]);
                    *(u32x4*)(rowp + bj * HALF) = w; } }
    }
};
template <bool NORM> struct EpiSwiGLU {
    static constexpr bool PERM = true, AFTER_DRAIN = false;
    bf16_t* O; int ldc; const float* ss;
    __device__ __forceinline__ float act(float g, float u) const { const float e = __builtin_amdgcn_exp2f(-g * 1.4426950408889634f); return g * u * __builtin_amdgcn_rcpf(1.0f + e); }
    __device__ __forceinline__ void operator()(const f32x4 (&acc)[2][2][4][2], const Unit& u, int wr, int wc, int fr, int fq) const {
        const int row0 = u.pm * BM + wr * 64 + fr; const int col0 = u.pn * HALF + wc * 32 + 8 * fq;
#pragma unroll
        for (int ai = 0; ai < 2; ++ai)
#pragma unroll
            for (int m = 0; m < 4; ++m) { const int row = row0 + ai * HALF + m * 16; bf16_t* rowp = O + (size_t)row * ldc + col0;
                float rs = 1.0f; if constexpr (NORM) rs = 1.0f / sqrtf(ss[row] * (1.0f / 2048.0f) + 1e-6f);
                const f32x4 g0 = acc[ai][0][m][0] * rs, g1 = acc[ai][0][m][1] * rs, u0 = acc[ai][1][m][0] * rs, u1 = acc[ai][1][m][1] * rs;
                u32x4 w; w.x = cvt_pk_bf16(act(g0[0], u0[0]), act(g0[1], u0[1])); w.y = cvt_pk_bf16(act(g0[2], u0[2]), act(g0[3], u0[3]));
                w.z = cvt_pk_bf16(act(g1[0], u1[0]), act(g1[1], u1[1])); w.w = cvt_pk_bf16(act(g1[2], u1[2]), act(g1[3], u1[3]));
                *(u32x4*)rowp = w; }
    }
};
template <bool BASE_BF16, bool WRITE_F32, bool WRITE_XB> struct EpiRes {
    static constexpr bool PERM = true, AFTER_DRAIN = false;
    const float* base; const bf16_t* baseb; float* out; bf16_t* xb; float* ss; int ldc; float alpha;
    __device__ __forceinline__ void operator()(const f32x4 (&acc)[2][2][4][2], const Unit& u, int wr, int wc, int fr, int fq) const {
        const int row0 = u.pm * BM + wr * 64 + fr; const int col0 = u.pn * BM + wc * 32 + 8 * fq;
#pragma unroll
        for (int ai = 0; ai < 2; ++ai)
#pragma unroll
            for (int m = 0; m < 4; ++m) { const int row = row0 + ai * HALF + m * 16; const size_t off = (size_t)row * ldc + col0; float part = 0.f;
#pragma unroll
                for (int bj = 0; bj < 2; ++bj) { const size_t idx = off + bj * HALF;
                    f32x4 b0, b1;
                    if constexpr (BASE_BF16) { const u32x4 r = *(const u32x4*)(baseb + idx);
                        b0 = (f32x4){__builtin_bit_cast(float, r.x << 16), __builtin_bit_cast(float, r.x & 0xffff0000u), __builtin_bit_cast(float, r.y << 16), __builtin_bit_cast(float, r.y & 0xffff0000u)};
                        b1 = (f32x4){__builtin_bit_cast(float, r.z << 16), __builtin_bit_cast(float, r.z & 0xffff0000u), __builtin_bit_cast(float, r.w << 16), __builtin_bit_cast(float, r.w & 0xffff0000u)}; }
                    else { b0 = *(const f32x4*)(base + idx); b1 = *(const f32x4*)(base + idx + 4); }
                    const f32x4 o0 = b0 + acc[ai][bj][m][0] * alpha, o1 = b1 + acc[ai][bj][m][1] * alpha;
                    if constexpr (WRITE_F32) { *(f32x4*)(out + idx) = o0; *(f32x4*)(out + idx + 4) = o1; }
                    if constexpr (WRITE_XB) {
                        part += (o0[0] * o0[0] + o0[1] * o0[1]) + (o0[2] * o0[2] + o0[3] * o0[3]) + (o1[0] * o1[0] + o1[1] * o1[1]) + (o1[2] * o1[2] + o1[3] * o1[3]);
                        u32x4 w; w.x = cvt_pk_bf16(o0[0], o0[1]); w.y = cvt_pk_bf16(o0[2], o0[3]); w.z = cvt_pk_bf16(o1[0], o1[1]); w.w = cvt_pk_bf16(o1[2], o1[3]);
                        *(u32x4*)(xb + idx) = w; } }
                if constexpr (WRITE_XB) { part += __shfl_xor(part, 16); part += __shfl_xor(part, 32);
                    if (fq == 0) atomicAdd(ss + row, part); } }
    }
};
struct EpiFinal {
    static constexpr bool PERM = true, AFTER_DRAIN = false;
    const bf16_t* baseb; float* out; float* ss; unsigned* cnt; const float* gain; int ldc; float alpha; unsigned ntn;
    __device__ __forceinline__ void tile(const f32x4 (&acc)[2][2][4][2], int ai, int m, int bj, size_t idx, f32x4& o0, f32x4& o1) const {
        const u32x4 r = *(const u32x4*)(baseb + idx);
        const f32x4 b0 = (f32x4){__builtin_bit_cast(float, r.x << 16), __builtin_bit_cast(float, r.x & 0xffff0000u), __builtin_bit_cast(float, r.y << 16), __builtin_bit_cast(float, r.y & 0xffff0000u)};
        const f32x4 b1 = (f32x4){__builtin_bit_cast(float, r.z << 16), __builtin_bit_cast(float, r.z & 0xffff0000u), __builtin_bit_cast(float, r.w << 16), __builtin_bit_cast(float, r.w & 0xffff0000u)};
        o0 = b0 + acc[ai][bj][m][0] * alpha; o1 = b1 + acc[ai][bj][m][1] * alpha;
    }
    __device__ __forceinline__ void operator()(const f32x4 (&acc)[2][2][4][2], const Unit& u, int wr, int wc, int fr, int fq) const {
        const int row0 = u.pm * BM + wr * 64 + fr; const int col0 = u.pn * BM + wc * 32 + 8 * fq;
#pragma unroll
        for (int ai = 0; ai < 2; ++ai)
#pragma unroll
            for (int m = 0; m < 4; ++m) { const int row = row0 + ai * HALF + m * 16; const size_t off = (size_t)row * ldc + col0; float part = 0.f;
#pragma unroll
                for (int bj = 0; bj < 2; ++bj) { f32x4 o0, o1; tile(acc, ai, m, bj, off + bj * HALF, o0, o1);
                    part += (o0[0] * o0[0] + o0[1] * o0[1]) + (o0[2] * o0[2] + o0[3] * o0[3]) + (o1[0] * o1[0] + o1[1] * o1[1]) + (o1[2] * o1[2] + o1[3] * o1[3]); }
                part += __shfl_xor(part, 16); part += __shfl_xor(part, 32);
                if (fq == 0) atomicAdd(ss + row, part); }
        asm volatile("s_waitcnt vmcnt(0)" ::: "memory");
        __builtin_amdgcn_s_barrier();
        if (threadIdx.x == 0) {
            unsigned* c = cnt + 64 * u.pm;
            __hip_atomic_fetch_add(c, 1u, __ATOMIC_RELAXED, __HIP_MEMORY_SCOPE_AGENT);
            unsigned sp = 0;
            while (__hip_atomic_load(c, __ATOMIC_RELAXED, __HIP_MEMORY_SCOPE_AGENT) < ntn) { __builtin_amdgcn_s_sleep(2); if (++sp > (1u << 22)) break; }
        }
        asm volatile("s_waitcnt vmcnt(0) lgkmcnt(0)" ::: "memory");
        __builtin_amdgcn_s_barrier(); asm volatile("" ::: "memory");
        f32x4 gv[2][2];
#pragma unroll
        for (int bj = 0; bj < 2; ++bj) { gv[bj][0] = *(const f32x4*)(gain + col0 + bj * HALF); gv[bj][1] = *(const f32x4*)(gain + col0 + bj * HALF + 4); }
#pragma unroll
        for (int ai = 0; ai < 2; ++ai)
#pragma unroll
            for (int m = 0; m < 4; ++m) { const int row = row0 + ai * HALF + m * 16; const size_t off = (size_t)row * ldc + col0;
                const float sv = __hip_atomic_load(ss + row, __ATOMIC_RELAXED, __HIP_MEMORY_SCOPE_AGENT);
                const float rs = 1.0f / sqrtf(sv * (1.0f / 2048.0f) + 1e-6f);
#pragma unroll
                for (int bj = 0; bj < 2; ++bj) { f32x4 o0, o1; const size_t idx = off + bj * HALF; tile(acc, ai, m, bj, idx, o0, o1);
                    *(f32x4*)(out + idx) = o0 * rs * gv[bj][0]; *(f32x4*)(out + idx + 4) = o1 * rs * gv[bj][1]; } }
    }
};
struct EpiResidX {
    static constexpr bool PERM = true, AFTER_DRAIN = false;
    const float* base; float* out; bf16_t* xb; float* ss; int ldc; float alpha;
    __device__ __forceinline__ void operator()(const f32x4 (&acc)[2][2][4][2], const Unit& u, int wr, int wc, int fr, int fq) const {
        const int row0 = u.pm * BM + wr * 64 + fr; const int col0 = u.pn * BM + wc * 32 + 8 * fq;
#pragma unroll
        for (int ai = 0; ai < 2; ++ai)
#pragma unroll
            for (int m = 0; m < 4; ++m) { const int row = row0 + ai * HALF + m * 16; const size_t off = (size_t)row * ldc + col0; float part = 0.f;
#pragma unroll
                for (int bj = 0; bj < 2; ++bj) { const size_t idx = off + bj * HALF;
                    const f32x4 b0 = *(const f32x4*)(base + idx), b1 = *(const f32x4*)(base + idx + 4);
                    const f32x4 o0 = b0 + acc[ai][bj][m][0] * alpha, o1 = b1 + acc[ai][bj][m][1] * alpha;
                    *(f32x4*)(out + idx) = o0; *(f32x4*)(out + idx + 4) = o1;
                    part += (o0[0] * o0[0] + o0[1] * o0[1]) + (o0[2] * o0[2] + o0[3] * o0[3]) + (o1[0] * o1[0] + o1[1] * o1[1]) + (o1[2] * o1[2] + o1[3] * o1[3]);
                    u32x4 w; w.x = cvt_pk_bf16(o0[0], o0[1]); w.y = cvt_pk_bf16(o0[2], o0[3]); w.z = cvt_pk_bf16(o1[0], o1[1]); w.w = cvt_pk_bf16(o1[2], o1[3]);
                    *(u32x4*)(xb + idx) = w; }
                part += __shfl_xor(part, 16); part += __shfl_xor(part, 32);
                if (fq == 0) atomicAdd(ss + row, part); }
    }
};
struct EpiResid {
    static constexpr bool PERM = false, AFTER_DRAIN = false;
    const float* base; float* out; int ldc; float alpha;
    __device__ __forceinline__ void operator()(const f32x4 (&acc)[2][2][4][2], const Unit& u, int wr, int wc, int fr, int fq) const {
        const int row0 = u.pm * BM + wr * 64 + fr; const int col0 = u.pn * BM + wc * 32 + 4 * fq;
#pragma unroll
        for (int ai = 0; ai < 2; ++ai)
#pragma unroll
            for (int m = 0; m < 4; ++m) { const size_t off = (size_t)(row0 + ai * HALF + m * 16) * ldc + col0;
#pragma unroll
                for (int bj = 0; bj < 2; ++bj)
#pragma unroll
                    for (int n = 0; n < 2; ++n) { const size_t idx = off + bj * HALF + n * 16; const f32x4 b = *(const f32x4*)(base + idx);
                        *(f32x4*)(out + idx) = b + acc[ai][bj][m][n] * alpha; } }
    }
};

template <class Epi, class Sched, bool ALIGN_EPI = false, bool SP2 = false>
__device__ __forceinline__ void gemm_phase(PG8_LAS unsigned char* lds, const Gemm g, const Sched& S, const Epi& E) {
    int tid = threadIdx.x; asm volatile("" : "+v"(tid));
    const int wid = __builtin_amdgcn_readfirstlane(tid >> 6), lane = tid & 63, wr = wid >> 2, wc = wid & 3, fr = lane & 15, fq = lane >> 4;
    const int K = g.K, nt = K / BK;
    unsigned voffA[2], voffB[2];
#pragma unroll
    for (int i = 0; i < 2; ++i) { int R, C; stage_rc(tid * 16 + i * 8192, R, C); const int Rb = Epi::PERM ? ((R & ~31) + perm32(R & 31)) : R;
        voffA[i] = (unsigned)(R * K + C) * 2u; voffB[i] = (unsigned)(Rb * K + C) * 2u; }
    const size_t kstep = (size_t)(BK * 2);
    const size_t hstep = (size_t)HALF * K * 2;
    const size_t tstep = 2 * hstep;
    const unsigned ldsw = (unsigned)wid * 1024u;
    const int aoff = lds_byte(wr * 64 + fr, fq * 8), boff = lds_byte(wc * 32 + fr, fq * 8);
#define PG8_SA(b, h) (((b) * 2 + (h)) * HTB)
#define PG8_SB(b, h) ((4 + (b) * 2 + (h)) * HTB)
#define PG8_STAGE(bufoff, gbase, voff) do { _Pragma("unroll") for (int _i = 0; _i < 2; ++_i) \
        __builtin_amdgcn_global_load_lds((const unsigned*)((const char*)(gbase) + (voff)[_i]), (PG8_LAS unsigned*)(lds + (bufoff) + ldsw + _i * 8192), 16, 0, 0); } while (0)
#define PG8_LDA(dst, b, h) do { _Pragma("unroll") for (int m = 0; m < 4; ++m) _Pragma("unroll") for (int k = 0; k < 2; ++k) dst[m][k] = *(const PG8_LAS bf16x8*)(lds + PG8_SA(b, h) + aoff + m * 2048 + k * 1024); } while (0)
#define PG8_LDB(dst, b, h) do { _Pragma("unroll") for (int n = 0; n < 2; ++n) _Pragma("unroll") for (int k = 0; k < 2; ++k) dst[n][k] = *(const PG8_LAS bf16x8*)(lds + PG8_SB(b, h) + boff + n * 2048 + k * 1024); } while (0)
#define PG8_MMA(ai, bj, At, Bt) do { __builtin_amdgcn_s_setprio(1); _Pragma("unroll") for (int m = 0; m < 4; ++m) _Pragma("unroll") for (int n = 0; n < 2; ++n) _Pragma("unroll") for (int k = 0; k < 2; ++k) \
        acc[ai][bj][m][n] = __builtin_amdgcn_mfma_f32_16x16x32_bf16(Bt[n][k], At[m][k], acc[ai][bj][m][n], 0, 0, 0); __builtin_amdgcn_s_setprio(0); } while (0)
#define PG8_WAIT_V(n) asm volatile("s_waitcnt vmcnt(" #n ")" ::: "memory")
#define PG8_WAIT_L(n) asm volatile("s_waitcnt lgkmcnt(" #n ")" ::: "memory")
#define PG8_BAR __builtin_amdgcn_s_barrier()
#define PG8_SCHED __builtin_amdgcn_sched_barrier(0)
    Unit cur, nxt; int ui = 0;
    if (!S.next(0, cur)) return;
    f32x4 acc[2][2][4][2];
#pragma unroll
    for (int a = 0; a < 2; ++a)
#pragma unroll
        for (int b = 0; b < 2; ++b)
#pragma unroll
            for (int m = 0; m < 4; ++m)
#pragma unroll
                for (int n = 0; n < 2; ++n) acc[a][b][m][n] = (f32x4){0.f, 0.f, 0.f, 0.f};
    bf16x8 At[4][2], B0[2][2], B1[2][2];
    const char* cA = (const char*)g.A + (size_t)cur.pm * tstep; const char* cB = (const char*)g.Bt + (size_t)cur.pn * tstep;
    S.a_ready(cur);
    if constexpr (SP2) {
        PG8_STAGE(PG8_SB(0, 0), cB, voffB); PG8_STAGE(PG8_SB(0, 1), cB + hstep, voffB); PG8_STAGE(PG8_SA(0, 0), cA, voffA); PG8_STAGE(PG8_SA(0, 1), cA + hstep, voffA);
        if (wr == 1) PG8_BAR;
        PG8_WAIT_V(2); PG8_BAR;
        PG8_STAGE(PG8_SB(1, 0), cB + kstep, voffB); PG8_STAGE(PG8_SA(1, 0), cA + kstep, voffA); PG8_STAGE(PG8_SB(1, 1), cB + hstep + kstep, voffB);
        PG8_WAIT_V(6); PG8_BAR;
    } else {
        PG8_STAGE(PG8_SB(0, 0), cB, voffB); PG8_STAGE(PG8_SA(0, 0), cA, voffA); PG8_STAGE(PG8_SB(0, 1), cB + hstep, voffB); PG8_STAGE(PG8_SA(0, 1), cA + hstep, voffA);
        if (wr == 1) PG8_BAR;
        PG8_WAIT_V(4); PG8_BAR;
        PG8_STAGE(PG8_SB(1, 0), cB + kstep, voffB); PG8_STAGE(PG8_SA(1, 0), cA + kstep, voffA); PG8_STAGE(PG8_SB(1, 1), cB + hstep + kstep, voffB);
        PG8_WAIT_V(6); PG8_BAR;
    }
    for (;;) {
        const bool has_next = S.next(ui + 1, nxt);
        const char* nA = has_next ? (const char*)g.A + (size_t)nxt.pm * tstep : cA; const char* nB = has_next ? (const char*)g.Bt + (size_t)nxt.pn * tstep : cB;
        for (int t = 0; t < nt; t += 2) {
            const bool last = (t == nt - 2);
            const char* a1 = cA + (size_t)(t + 1) * kstep;
            const char* a2 = last ? nA : cA + (size_t)(t + 2) * kstep; const char* b2 = last ? nB : cB + (size_t)(t + 2) * kstep;
            const char* a3 = a2 + kstep; const char* b3 = b2 + kstep;
            if (last && has_next) S.a_ready(nxt);
            if constexpr (SP2) {
            PG8_LDB(B0, 0, 0); PG8_LDB(B1, 0, 1); PG8_SCHED; PG8_LDA(At, 0, 0); PG8_STAGE(PG8_SA(1, 1), a1 + hstep, voffA);
            PG8_WAIT_V(8); PG8_WAIT_L(0); PG8_BAR; PG8_MMA(0, 0, At, B0); PG8_MMA(0, 1, At, B1); PG8_BAR; PG8_SCHED;
            PG8_LDA(At, 0, 1); PG8_STAGE(PG8_SB(0, 0), b2, voffB); PG8_STAGE(PG8_SB(0, 1), b2 + hstep, voffB); PG8_STAGE(PG8_SA(0, 0), a2, voffA);
            PG8_WAIT_V(8); PG8_WAIT_L(0); PG8_BAR; PG8_MMA(1, 0, At, B0); PG8_MMA(1, 1, At, B1); PG8_BAR; PG8_SCHED;
            PG8_LDB(B0, 1, 0); PG8_LDB(B1, 1, 1); PG8_SCHED; PG8_LDA(At, 1, 0); PG8_STAGE(PG8_SA(0, 1), a2 + hstep, voffA);
            PG8_WAIT_V(8); PG8_WAIT_L(0); PG8_BAR; PG8_MMA(0, 0, At, B0); PG8_MMA(0, 1, At, B1); PG8_BAR; PG8_SCHED;
            PG8_LDA(At, 1, 1); PG8_STAGE(PG8_SB(1, 0), b3, voffB); PG8_STAGE(PG8_SB(1, 1), b3 + hstep, voffB); PG8_STAGE(PG8_SA(1, 0), a3, voffA);
            PG8_WAIT_V(8); PG8_WAIT_L(0); PG8_BAR; PG8_MMA(1, 0, At, B0); PG8_MMA(1, 1, At, B1); PG8_BAR; PG8_SCHED;
            } else {
            PG8_LDB(B0, 0, 0); PG8_SCHED; PG8_LDA(At, 0, 0); PG8_STAGE(PG8_SA(1, 1), a1 + hstep, voffA);
            PG8_WAIT_L(8); PG8_BAR; PG8_WAIT_L(0); PG8_MMA(0, 0, At, B0); PG8_BAR; PG8_SCHED;
            PG8_LDB(B1, 0, 1); PG8_STAGE(PG8_SB(0, 0), b2, voffB);
            PG8_BAR; PG8_WAIT_L(0); PG8_MMA(0, 1, At, B1); PG8_BAR;
            PG8_LDA(At, 0, 1); PG8_STAGE(PG8_SA(0, 0), a2, voffA);
            PG8_BAR; PG8_WAIT_L(0); PG8_MMA(1, 0, At, B0); PG8_BAR; PG8_SCHED;
            PG8_STAGE(PG8_SB(0, 1), b2 + hstep, voffB);
            PG8_WAIT_V(6); PG8_BAR; PG8_MMA(1, 1, At, B1); PG8_BAR;
            PG8_LDB(B0, 1, 0); PG8_SCHED; PG8_LDA(At, 1, 0); PG8_STAGE(PG8_SA(0, 1), a2 + hstep, voffA);
            PG8_WAIT_L(8); PG8_BAR; PG8_WAIT_L(0); PG8_MMA(0, 0, At, B0); PG8_BAR; PG8_SCHED;
            PG8_LDB(B1, 1, 1); PG8_STAGE(PG8_SB(1, 0), b3, voffB);
            PG8_BAR; PG8_WAIT_L(0); PG8_MMA(0, 1, At, B1); PG8_BAR;
            PG8_LDA(At, 1, 1); PG8_STAGE(PG8_SA(1, 0), a3, voffA);
            PG8_BAR; PG8_WAIT_L(0); PG8_MMA(1, 0, At, B0); PG8_BAR; PG8_SCHED;
            PG8_STAGE(PG8_SB(1, 1), b3 + hstep, voffB);
            PG8_WAIT_V(6); PG8_BAR; PG8_MMA(1, 1, At, B1); PG8_BAR;
            }
        }
        if constexpr (ALIGN_EPI) { if (wr == 0) PG8_BAR; }
        if constexpr (!Epi::AFTER_DRAIN) { E(acc, cur, wr, wc, fr, fq); S.done(cur); }
        if (!has_next) break;
#pragma unroll
        for (int a = 0; a < 2; ++a)
#pragma unroll
            for (int b = 0; b < 2; ++b)
#pragma unroll
                for (int m = 0; m < 4; ++m)
#pragma unroll
                    for (int n = 0; n < 2; ++n) acc[a][b][m][n] = (f32x4){0.f, 0.f, 0.f, 0.f};
        cur = nxt; cA = nA; cB = nB; ++ui;
        if constexpr (ALIGN_EPI) { if (wr == 1) PG8_BAR; }
    }
    PG8_WAIT_V(0);
    if constexpr (!ALIGN_EPI) { if (wr == 0) PG8_BAR; }
    PG8_BAR;
#undef PG8_SA
#undef PG8_SB
#undef PG8_STAGE
#undef PG8_LDA
#undef PG8_LDB
#undef PG8_MMA
#undef PG8_WAIT_V
#undef PG8_WAIT_L
#undef PG8_BAR
#undef PG8_SCHED
}
}

namespace att {
using bf16 = __hip_bfloat16;
constexpr int D = 128, NW = 8, QBLK = 32, KVBLK = 64;
constexpr float SCALE = 0.088388347648318440f;
constexpr float THR = 8.f;
constexpr size_t SHM_V = KVBLK * D * 2, SHM_K = KVBLK * D * 2, SHM_ATTN = 2 * SHM_V + 2 * SHM_K + NW * 64 * 4;
constexpr int TAB_N = 640, TAB_PAD = 320;
using bf16x8 = __attribute__((ext_vector_type(8))) short;
using s16x4  = __attribute__((ext_vector_type(4))) short;
using f32x16 = __attribute__((ext_vector_type(16))) float;
using u32x4  = __attribute__((ext_vector_type(4))) unsigned;
#define KSWZ(row, colB) ((row) * 256 + ((colB) ^ (((row) & 7) << 4)))
#define SBAR() __builtin_amdgcn_sched_barrier(0)
__device__ __forceinline__ int crow(int r, int hi) { return (r & 3) + 8 * (r >> 2) + 4 * hi; }
__device__ __forceinline__ unsigned cvtpk(float lo, float hi) { unsigned r; asm volatile("v_cvt_pk_bf16_f32 %0, %1, %2" : "=v"(r) : "v"(lo), "v"(hi)); return r; }

__device__ __forceinline__ void partialSM(f32x16& p0, f32x16& p1, float& m_reg, float& mn, float& alpha) {
  constexpr float C = SCALE * 1.4426950408889634f;
  float pmax = p0[0];
#pragma unroll
  for (int r = 1; r < 16; ++r) pmax = fmaxf(pmax, p0[r]);
#pragma unroll
  for (int r = 0; r < 16; ++r) pmax = fmaxf(pmax, p1[r]);
  { auto rr = __builtin_amdgcn_permlane32_swap(__float_as_uint(pmax), __float_as_uint(pmax), false, false);
    pmax = fmaxf(__uint_as_float(rr[0]), __uint_as_float(rr[1])); }
  if (__builtin_expect(__all(pmax - m_reg <= THR / SCALE), 1)) { mn = m_reg; alpha = 1.f; }
  else { mn = fmaxf(m_reg, pmax); alpha = __builtin_amdgcn_exp2f((m_reg - mn) * C); m_reg = mn; }
  float mnC = -mn * C;
#pragma unroll
  for (int r = 0; r < 16; ++r) p0[r] = fmaf(p0[r], C, mnC);
#pragma unroll
  for (int r = 0; r < 16; ++r) p1[r] = fmaf(p1[r], C, mnC);
#pragma unroll
  for (int r = 0; r < 16; ++r) p0[r] = __builtin_amdgcn_exp2f(p0[r]);
}
__device__ __forceinline__ void finishSM(f32x16& p0, f32x16& p1, float alpha, float& l_reg, bf16x8& pa0, bf16x8& pa1, bf16x8& pa2, bf16x8& pa3) {
#pragma unroll
  for (int r = 0; r < 16; ++r) p1[r] = __builtin_amdgcn_exp2f(p1[r]);
  float ps = 0;
#pragma unroll
  for (int r = 0; r < 16; ++r) ps += p0[r];
#pragma unroll
  for (int r = 0; r < 16; ++r) ps += p1[r];
  { auto rr = __builtin_amdgcn_permlane32_swap(__float_as_uint(ps), __float_as_uint(ps), false, false);
    ps = __uint_as_float(rr[0]) + __uint_as_float(rr[1]); }
  l_reg = l_reg * alpha + ps;
#define PK4(P, BASE, OUT) do { unsigned a0 = cvtpk(P[BASE + 0], P[BASE + 1]), a1 = cvtpk(P[BASE + 2], P[BASE + 3]);   \
    unsigned b0 = cvtpk(P[BASE + 4], P[BASE + 5]), b1 = cvtpk(P[BASE + 6], P[BASE + 7]);                              \
    auto r0 = __builtin_amdgcn_permlane32_swap(a0, b0, false, false); auto r1 = __builtin_amdgcn_permlane32_swap(a1, b1, false, false); \
    u32x4 w = {r0[0], r1[0], r0[1], r1[1]}; OUT = *reinterpret_cast<bf16x8*>(&w); } while (0)
  PK4(p0, 0, pa0); PK4(p0, 8, pa1); PK4(p1, 0, pa2); PK4(p1, 8, pa3);
#undef PK4
}
__device__ __forceinline__ void qkt(f32x16& p0, f32x16& p1, const bf16* Ks, const bf16x8* qr, int r32, int hi) {
  p0 = f32x16{}; p1 = f32x16{};
#pragma unroll
  for (int d0 = 0; d0 < 8; ++d0) { int cb = (d0 * 16 + hi * 8) * 2;
    bf16x8 b0 = *reinterpret_cast<const bf16x8*>((const char*)Ks + KSWZ(r32, cb));
    bf16x8 b1 = *reinterpret_cast<const bf16x8*>((const char*)Ks + KSWZ(32 + r32, cb));
    p0 = __builtin_amdgcn_mfma_f32_32x32x16_bf16(b0, qr[d0], p0, 0, 0, 0);
    p1 = __builtin_amdgcn_mfma_f32_32x32x16_bf16(b1, qr[d0], p1, 0, 0, 0); }
}
__device__ __forceinline__ int v_st(int k, int c) { const int kk = (k & ~0xC) | ((k & 4) << 1) | ((k & 8) >> 1); return ((kk >> 3) * 4 + (c >> 5)) * 512 + ((kk & 7) * 32 + (c & 31)) * 2; }
__device__ __forceinline__ int v_rd_base(int lane) { return ((lane & 3) << 3) | (((lane >> 2) & 3) << 6) | (((lane >> 4) & 1) << 5) | (((lane >> 5) & 1) << 8); }
constexpr int v_rd_off(int d0, int ks, int half) { return d0 * 512 + ks * 4096 + half * 2048; }
template <int OFF> __device__ __forceinline__ s16x4 tr_read(int vb) {
  s16x4 r; asm volatile("ds_read_b64_tr_b16 %0, %1 offset:%2" : "=&v"(r) : "v"(vb), "i"(OFF) : "memory"); return r;
}
template <int D0> __device__ __forceinline__ void pv_one(f32x16& od, int vb, bf16x8 pa0, bf16x8 pa1, bf16x8 pa2, bf16x8 pa3) {
  const s16x4 l0 = tr_read<v_rd_off(D0, 0, 0)>(vb), h0 = tr_read<v_rd_off(D0, 0, 1)>(vb), l1 = tr_read<v_rd_off(D0, 1, 0)>(vb), h1 = tr_read<v_rd_off(D0, 1, 1)>(vb);
  const s16x4 l2 = tr_read<v_rd_off(D0, 2, 0)>(vb), h2 = tr_read<v_rd_off(D0, 2, 1)>(vb), l3 = tr_read<v_rd_off(D0, 3, 0)>(vb), h3 = tr_read<v_rd_off(D0, 3, 1)>(vb);
  asm volatile("s_waitcnt lgkmcnt(0)" ::: "memory"); SBAR();
#define PK(L, H) (bf16x8){L[0], L[1], L[2], L[3], H[0], H[1], H[2], H[3]}
  od = __builtin_amdgcn_mfma_f32_32x32x16_bf16(pa0, PK(l0, h0), od, 0, 0, 0);
  od = __builtin_amdgcn_mfma_f32_32x32x16_bf16(pa1, PK(l1, h1), od, 0, 0, 0);
  od = __builtin_amdgcn_mfma_f32_32x32x16_bf16(pa2, PK(l2, h2), od, 0, 0, 0);
  od = __builtin_amdgcn_mfma_f32_32x32x16_bf16(pa3, PK(l3, h3), od, 0, 0, 0);
#undef PK
}
__device__ __forceinline__ void pv_d0(f32x16* o, int vb, bf16x8 pa0, bf16x8 pa1, bf16x8 pa2, bf16x8 pa3) {
  pv_one<0>(o[0], vb, pa0, pa1, pa2, pa3); pv_one<1>(o[1], vb, pa0, pa1, pa2, pa3); pv_one<2>(o[2], vb, pa0, pa1, pa2, pa3); pv_one<3>(o[3], vb, pa0, pa1, pa2, pa3);
}

template <int MODE, bool QPREP = false>
__device__ __forceinline__ void attn_unit(const bf16* __restrict__ Qb, long ldq, const bf16* __restrict__ Kh, const bf16* __restrict__ Vh, long ldk,
                                          bf16* Ob, long ldo, int NT, char* lds, int kpos0, int npos, const float* tab, float* lse_out, long lse_stride, const float* qgain = nullptr, int qs0 = 0) {
  int tid = threadIdx.x; asm volatile("" : "+v"(tid));
  const int wid = __builtin_amdgcn_readfirstlane(tid >> 6), lane = tid & 63, r32 = lane & 31, hi = lane >> 5;
  constexpr int KOFF = (MODE == 0) ? 0 : (int)(2 * SHM_V), VOFF = (MODE == 0) ? 65536 : 0, WSOFF = (MODE == 0) ? (131072 + 1024) : (int)(2 * SHM_V + 2 * SHM_K);
  bf16* V_lds = (bf16*)(lds + VOFF); bf16* K_lds = (bf16*)(lds + KOFF);
  float* ws = (float*)(lds + WSOFF) + wid * 64; float* li_l = ws; float* al_l = ws + 32;
  float m_reg = -1e30f, l_reg = 0; f32x16 o[4] = {}; bf16x8 qr[8];
  const bf16* Qw = Qb + (long)(wid * QBLK + r32) * ldq + hi * 8;
#pragma unroll
  for (int d0 = 0; d0 < 8; ++d0) qr[d0] = *reinterpret_cast<const bf16x8*>(Qw + d0 * 16);
  if constexpr (QPREP) {
    float x[8][8]; float ssq = 0.f;
#pragma unroll
    for (int d0 = 0; d0 < 8; ++d0)
#pragma unroll
      for (int j = 0; j < 8; ++j) { x[d0][j] = __builtin_bit_cast(float, (unsigned)(unsigned short)qr[d0][j] << 16); ssq += x[d0][j] * x[d0][j]; }
    { auto rr = __builtin_amdgcn_permlane32_swap(__float_as_uint(ssq), __float_as_uint(ssq), false, false); ssq = __uint_as_float(rr[0]) + __uint_as_float(rr[1]); }
    const float rstd = 1.0f / sqrtf(ssq * (1.0f / 128.0f) + 1e-6f);
    const int sq = qs0 + wid * QBLK + r32;
#pragma unroll
    for (int aa = 0; aa < 2; ++aa) { const float pos = (float)(aa == 0 ? (sq >> 6) : (sq & 63));
#pragma unroll
      for (int dd = 0; dd < 2; ++dd) { const int d0 = aa * 4 + dd;
#pragma unroll
        for (int j = 0; j < 8; ++j) { const int i = 16 * dd + 8 * hi + j; const int e1 = aa * 64 + i;
          const float rev = pos * exp2f(-(float)i * 0.41524101186092029f) * 0.15915494309189535f;
          const float sn = __builtin_amdgcn_sinf(rev), cs = __builtin_amdgcn_cosf(rev);
          const float y1 = x[d0][j] * rstd * qgain[e1], y2 = x[d0 + 2][j] * rstd * qgain[e1 + 32];
          x[d0][j] = y1 * cs - y2 * sn; x[d0 + 2][j] = y2 * cs + y1 * sn; } } }
#pragma unroll
    for (int d0 = 0; d0 < 8; ++d0) { u32x4 w = {cvtpk(x[d0][0], x[d0][1]), cvtpk(x[d0][2], x[d0][3]), cvtpk(x[d0][4], x[d0][5]), cvtpk(x[d0][6], x[d0][7])}; qr[d0] = *reinterpret_cast<bf16x8*>(&w); }
  }
  const int sr = tid >> 4, sc = (tid & 15) * 8, vst0 = v_st(sr, sc), vst1 = vst0 + 8192;
  const int vb0 = (int)(uintptr_t)V_lds + v_rd_base(lane);
  const int qrel = wid * QBLK + r32;
  constexpr int SD = (MODE == 0) ? ATT_SD0 : 2;
  struct { bf16x8 vs0, vs1, ks0, ks1; } sr_[SD];
  const unsigned soff0 = (unsigned)(sr * (int)ldk + sc) * 2u, soff1 = soff0 + (unsigned)(32 * (int)ldk) * 2u;
#define KPOS(j) ((MODE == 1) ? ((kpos0 + (j) * KVBLK >= 0 && kpos0 + (j) * KVBLK < npos) ? (kpos0 + (j) * KVBLK) : 0) : ((j) * KVBLK))
#define SLOAD(i, j) do { const size_t kb_ = (size_t)KPOS(j) * (size_t)ldk * 2; const char* Kt_ = (const char*)Kh + kb_; const char* Vt_ = (const char*)Vh + kb_; \
    sr_[i].vs0 = *reinterpret_cast<const bf16x8*>(Vt_ + soff0); sr_[i].vs1 = *reinterpret_cast<const bf16x8*>(Vt_ + soff1); \
    sr_[i].ks0 = *reinterpret_cast<const bf16x8*>(Kt_ + soff0); sr_[i].ks1 = *reinterpret_cast<const bf16x8*>(Kt_ + soff1); } while (0)
#define SWRITE(b, i) do { *(bf16x8*)((char*)V_lds + (b) * SHM_V + vst0) = sr_[i].vs0;          \
    *(bf16x8*)((char*)V_lds + (b) * SHM_V + vst1) = sr_[i].vs1; int kc = sc * 2;               \
    *(bf16x8*)((char*)K_lds + (b) * SHM_K + KSWZ(sr, kc)) = sr_[i].ks0;                       \
    *(bf16x8*)((char*)K_lds + (b) * SHM_K + KSWZ(32 + sr, kc)) = sr_[i].ks1; } while (0)
#define SWAIT() do { if constexpr (SD == 2) asm volatile("s_waitcnt vmcnt(4)" ::: "memory"); else asm volatile("s_waitcnt vmcnt(0)" ::: "memory"); } while (0)
#define RESC(a) do { if (__any((a) < 1.f)) { if (hi == 0) al_l[r32] = (a); asm volatile("s_waitcnt lgkmcnt(0)" ::: "memory"); \
    _Pragma("unroll") for (int d = 0; d < 4; ++d) _Pragma("unroll") for (int r = 0; r < 16; ++r) o[d][r] *= al_l[crow(r, hi)]; } } while (0)
#define BIASM(P0, P1, j) do { if constexpr (MODE == 1) { const int kp_ = kpos0 + (j) * KVBLK; \
    if (kp_ >= 0 && kp_ < npos) { const float* tb_ = tab + ((j) * KVBLK - 64 + 4 * hi - qrel + TAB_PAD); \
      _Pragma("unroll") for (int r = 0; r < 16; ++r) { P0[r] += tb_[(r & 3) + 8 * (r >> 2)]; P1[r] += tb_[32 + (r & 3) + 8 * (r >> 2)]; } } \
    else { _Pragma("unroll") for (int r = 0; r < 16; ++r) { P0[r] = -INFINITY; P1[r] = -INFINITY; } } } } while (0)
  if constexpr (MODE == 1) {
    f32x16 pA0, pA1; float mnA, alA; bf16x8 pa0, pa1, pa2, pa3;
    const int jlo = wid >> 1;
    SLOAD(0, 0); SLOAD(1, 1);
    for (int j = 0; j < NT; j += 2) {
      SWRITE(0, 0); __syncthreads();
      if (j + 2 < NT) SLOAD(0, j + 2);
      if (j >= jlo && j <= jlo + 2) {
        qkt(pA0, pA1, K_lds, qr, r32, hi); BIASM(pA0, pA1, j); partialSM(pA0, pA1, m_reg, mnA, alA);
        RESC(alA);
        finishSM(pA0, pA1, alA, l_reg, pa0, pa1, pa2, pa3); SBAR();
        pv_d0(o, vb0, pa0, pa1, pa2, pa3);
      }
      SWRITE(1, 1); __syncthreads();
      if (j + 3 < NT) SLOAD(1, j + 3);
      if (j + 1 >= jlo && j + 1 <= jlo + 2) {
        qkt(pA0, pA1, (bf16*)((char*)K_lds + SHM_K), qr, r32, hi); BIASM(pA0, pA1, j + 1); partialSM(pA0, pA1, m_reg, mnA, alA);
        RESC(alA);
        finishSM(pA0, pA1, alA, l_reg, pa0, pa1, pa2, pa3); SBAR();
        pv_d0(o, vb0 + (int)SHM_V, pa0, pa1, pa2, pa3);
      }
    }
  } else {
  f32x16 pA0, pA1, pB0, pB1; float mnA, mnB, alA, alB; bf16x8 pa0, pa1, pa2, pa3;
  bf16x8 pv0_, pv1_, pv2_, pv3_, pk0_, pk1_, pk2_, pk3_;
  const int NP = NT >> 1;
  const unsigned rstep = (unsigned)(32 * (int)ldk) * 2u;
#define PLOADK(pp) do { const size_t kb_ = (size_t)(pp) * 128 * (size_t)ldk * 2; const char* Kt_ = (const char*)Kh + kb_ + soff0; \
    pk0_ = *reinterpret_cast<const bf16x8*>(Kt_); pk1_ = *reinterpret_cast<const bf16x8*>(Kt_ + rstep); pk2_ = *reinterpret_cast<const bf16x8*>(Kt_ + 2 * rstep); pk3_ = *reinterpret_cast<const bf16x8*>(Kt_ + 3 * rstep); } while (0)
#define PLOADV(pp) do { const size_t kb_ = (size_t)(pp) * 128 * (size_t)ldk * 2; const char* Vt_ = (const char*)Vh + kb_ + soff0; \
    pv0_ = *reinterpret_cast<const bf16x8*>(Vt_); pv1_ = *reinterpret_cast<const bf16x8*>(Vt_ + rstep); pv2_ = *reinterpret_cast<const bf16x8*>(Vt_ + 2 * rstep); pv3_ = *reinterpret_cast<const bf16x8*>(Vt_ + 3 * rstep); } while (0)
#define PLOAD(pp) do { PLOADK(pp); PLOADV(pp); } while (0)
#define PWRITE(c) do { const int kc = sc * 2; char* vb_ = (char*)V_lds + (c) * 32768; char* kb2_ = (char*)K_lds + (c) * 32768; \
    *(bf16x8*)(vb_ + vst0) = pv0_; *(bf16x8*)(vb_ + vst1) = pv1_; *(bf16x8*)(vb_ + 16384 + vst0) = pv2_; *(bf16x8*)(vb_ + 16384 + vst1) = pv3_; \
    *(bf16x8*)(kb2_ + KSWZ(sr, kc)) = pk0_; *(bf16x8*)(kb2_ + KSWZ(32 + sr, kc)) = pk1_; *(bf16x8*)(kb2_ + 16384 + KSWZ(sr, kc)) = pk2_; *(bf16x8*)(kb2_ + 16384 + KSWZ(32 + sr, kc)) = pk3_; } while (0)
#define KSUB(c, sb) ((bf16*)((char*)K_lds + (c) * 32768 + (sb) * 16384))
#define VSUB(c, sb) (vb0 + (c) * 32768 + (sb) * 16384)
  PLOAD(0); asm volatile("s_waitcnt vmcnt(0)" ::: "memory"); PWRITE(0); __syncthreads();
  qkt(pA0, pA1, KSUB(0, 0), qr, r32, hi); partialSM(pA0, pA1, m_reg, mnA, alA);
#define PAIR_FULL(c, oc, NEXTP) do { \
    SBAR(); PLOADK(NEXTP); qkt(pB0, pB1, KSUB(c, 1), qr, r32, hi); \
    finishSM(pA0, pA1, alA, l_reg, pa0, pa1, pa2, pa3); SBAR(); \
    PLOADV(NEXTP); \
    pv_d0(o, VSUB(c, 0), pa0, pa1, pa2, pa3); partialSM(pB0, pB1, m_reg, mnB, alB); \
    RESC(alB); \
    PWRITE(oc); \
    __syncthreads(); \
    SBAR(); qkt(pA0, pA1, KSUB(oc, 0), qr, r32, hi); \
    finishSM(pB0, pB1, alB, l_reg, pa0, pa1, pa2, pa3); SBAR(); \
    pv_d0(o, VSUB(c, 1), pa0, pa1, pa2, pa3); partialSM(pA0, pA1, m_reg, mnA, alA); \
    RESC(alA); \
    __syncthreads(); } while (0)
  for (int p = 0; p + 2 < NP; p += 2) {
    PAIR_FULL(0, 1, p + 1);
    PAIR_FULL(1, 0, p + 2);
  }
  PAIR_FULL(0, 1, NP - 1);
  { SBAR(); qkt(pB0, pB1, KSUB(1, 1), qr, r32, hi);
    finishSM(pA0, pA1, alA, l_reg, pa0, pa1, pa2, pa3); SBAR();
    pv_d0(o, VSUB(1, 0), pa0, pa1, pa2, pa3); partialSM(pB0, pB1, m_reg, mnB, alB);
    RESC(alB);
    finishSM(pB0, pB1, alB, l_reg, pa0, pa1, pa2, pa3); SBAR();
    pv_d0(o, VSUB(1, 1), pa0, pa1, pa2, pa3); }
#undef PAIR_FULL
#undef PLOAD
#undef PLOADK
#undef PLOADV
#undef PWRITE
#undef KSUB
#undef VSUB
  }
  if (hi == 0) li_l[r32] = l_reg; asm volatile("s_waitcnt lgkmcnt(0)" ::: "memory");
  if constexpr (MODE == 1) { if (hi == 0) lse_out[(long)(wid * QBLK + r32) * lse_stride] = m_reg * SCALE + __logf(l_reg); }
  float rli[16];
#pragma unroll
  for (int r = 0; r < 16; ++r) rli[r] = __builtin_amdgcn_rcpf(li_l[crow(r, hi)]);
  bf16* Ow = Ob + (long)(wid * QBLK) * ldo;
#pragma unroll
  for (int r = 0; r < 16; ++r) { const int orow = crow(r, hi);
#pragma unroll
    for (int d0 = 0; d0 < 4; ++d0) Ow[(long)orow * ldo + d0 * 32 + r32] = __float2bfloat16(o[d0][r] * rli[r]); }
  __syncthreads();
#undef KPOS
#undef SLOAD
#undef SWRITE
#undef SWAIT
#undef RESC
#undef BIASM
}
#undef SBAR
}

constexpr int NWAVES = 8;
constexpr int DM = 2048, BATCH = 2, SEQ = 16384, MTOK = BATCH * SEQ, DFF = 5632, INW = 10752, MEMT = 256, MEMW = 512;
constexpr int O_QA = 0, O_KA = 1024, O_VA = 1280, O_QB = 1536, O_KB = 4608, O_VB = 7680;
constexpr float EPS = 1e-6f;
constexpr size_t MiB = 1u << 20;
constexpr size_t WS_WGU1 = 1 * MiB, WS_WD1 = WS_WGU1 + 44 * MiB, WS_WGU2 = WS_WD1 + 22 * MiB, WS_WD2 = WS_WGU2 + 44 * MiB, WS_WIN = WS_WD2 + 22 * MiB,
                 WS_WOUT = WS_WIN + 42 * MiB, WS_WQM = WS_WOUT + 8 * MiB, WS_WKVM = WS_WQM + 2 * MiB, WS_WOM = WS_WKVM + 4 * MiB, WS_HM = WS_WOM + 2 * MiB,
                 WS_KVM = WS_HM + 2 * MiB, WS_LSE = WS_KVM + 1 * MiB, WS_H = 200 * MiB, WS_PROJ = 328 * MiB, WS_END = 1000 * MiB;
static_assert(WS_LSE + 3 * MiB <= WS_H, "ws map");
constexpr size_t WS_ACT = WS_PROJ, WS_QM = WS_PROJ, WS_OM = WS_PROJ + 32 * MiB;
constexpr int RING_BYTES = 131072, LDS_BYTES = 131072 + 1024 + 2048;
constexpr int NPH = 17;

typedef unsigned short bf16r;
typedef float f32x4 __attribute__((ext_vector_type(4)));
typedef unsigned v4u __attribute__((ext_vector_type(4)));
#define LAS __attribute__((address_space(3)))

__device__ __forceinline__ unsigned f2bf(float f) { unsigned u = __builtin_bit_cast(unsigned, f); return (u + 0x7fffu + ((u >> 16) & 1u)) >> 16; }
__device__ __forceinline__ unsigned pk2(float lo, float hi) { return f2bf(lo) | (f2bf(hi) << 16); }
__device__ __forceinline__ float bf2f(unsigned short b) { return __builtin_bit_cast(float, (unsigned)b << 16); }
__device__ __forceinline__ float wave_sum(float v) {
#pragma unroll
    for (int o = 1; o < 64; o <<= 1) v += __shfl_xor(v, o);
    return v;
}
__device__ __forceinline__ void transpose_item(const float* W, int K, int N, bf16r* WT, int k0, int n0, int drow0, LAS float* scr, int lane, const float* gain) {
    { const int kr = lane >> 3, nq = lane & 7; f32x4 v[8];
#pragma unroll
      for (int i = 0; i < 8; ++i) v[i] = *(const f32x4*)(W + (size_t)(k0 + 8 * i + kr) * N + n0 + 4 * nq);
      if (gain) {
#pragma unroll
        for (int i = 0; i < 8; ++i) v[i] = v[i] * gain[k0 + 8 * i + kr]; }
#pragma unroll
      for (int i = 0; i < 8; ++i) { LAS float* d = scr + (8 * i + kr) * 33 + 4 * nq; d[0] = v[i].x; d[1] = v[i].y; d[2] = v[i].z; d[3] = v[i].w; } }
    asm volatile("s_waitcnt lgkmcnt(0)" ::: "memory");
    const int c = lane & 7;
#pragma unroll
    for (int j = 0; j < 4; ++j) { const int n = (lane >> 3) + 8 * j; const LAS float* s = scr + (8 * c) * 33 + n;
        v4u o; o.x = pk2(s[0 * 33], s[1 * 33]); o.y = pk2(s[2 * 33], s[3 * 33]); o.z = pk2(s[4 * 33], s[5 * 33]); o.w = pk2(s[6 * 33], s[7 * 33]);
        *(v4u*)(WT + (size_t)(drow0 + n) * K + k0 + 8 * c) = o; }
    asm volatile("s_waitcnt lgkmcnt(0)" ::: "memory");
}
__device__ __forceinline__ void transpose_mat(const float* W, int K, int N, bf16r* WT, int mode, int item, LAS float* scr, int lane, const float* gain = nullptr) {
    const int nblk = N / 32, kb = item / nblk, nb = item % nblk, k0 = 64 * kb, n0 = 32 * nb;
    int drow0 = n0;
    if (mode != 0) drow0 = (n0 >> 7) * 256 + (n0 & 127) + (mode == 2 ? 128 : 0);
    transpose_item(W, K, N, WT, k0, n0, drow0, scr, lane, gain);
}
__device__ __forceinline__ void rms_row_bf16(const float* xrow, const float* g, bf16r* orow, int lane) {
    const f32x4* xr = (const f32x4*)xrow + lane; f32x4 v[8]; float s = 0.f;
#pragma unroll
    for (int j = 0; j < 8; ++j) { v[j] = xr[64 * j]; s += (v[j].x * v[j].x + v[j].y * v[j].y) + (v[j].z * v[j].z + v[j].w * v[j].w); }
    const float rstd = 1.0f / sqrtf(wave_sum(s) * (1.f / DM) + EPS);
    const f32x4* gr = (const f32x4*)g + lane; unsigned long long* o8 = (unsigned long long*)orow + lane;
#pragma unroll
    for (int j = 0; j < 8; ++j) { const f32x4 gv = gr[64 * j]; const f32x4 y = v[j] * rstd * gv;
        o8[64 * j] = (unsigned long long)pk2(y.x, y.y) | ((unsigned long long)pk2(y.z, y.w) << 32); }
}
__device__ __forceinline__ void rms_row_f32(float* xrow, const float* g, int lane) {
    f32x4* xr = (f32x4*)xrow + lane; f32x4 v[8]; float s = 0.f;
#pragma unroll
    for (int j = 0; j < 8; ++j) { v[j] = xr[64 * j]; s += (v[j].x * v[j].x + v[j].y * v[j].y) + (v[j].z * v[j].z + v[j].w * v[j].w); }
    const float rstd = 1.0f / sqrtf(wave_sum(s) * (1.f / DM) + EPS);
    const f32x4* gr = (const f32x4*)g + lane;
#pragma unroll
    for (int j = 0; j < 8; ++j) { const f32x4 gv = gr[64 * j]; xr[64 * j] = v[j] * rstd * gv; }
}
__device__ __forceinline__ int t5_bucket(int rel) {
    const int n = rel < 0 ? -rel : rel; int v;
    if (n < 8) v = n; else v = 8 + (n >= 15) + (n >= 27) + (n >= 50) + (n >= 91) + (n >= 166) + (n >= 305) + (n >= 559);
    return (rel > 0 ? 16 : 0) + v;
}


#define RLX_AGENT __ATOMIC_RELAXED, __HIP_MEMORY_SCOPE_AGENT
#define XB_TMO      128
#define XB_XCNT(j)  (256  + 64 * (j))
#define XB_XSUB(j)  (1280 + 64 * (j))
#define XB_XGEN(j)  (2304 + 64 * (j))
#define XB_TOP      3328
#define XB_TOPGEN   3392
#define XCD_BAR_WORDS 3456
#define XB_SPIN_CAP (1u << 22)

__device__ __forceinline__ unsigned xb_ld(unsigned* p)              { return __hip_atomic_load(p, __ATOMIC_RELAXED, __HIP_MEMORY_SCOPE_AGENT); }
__device__ __forceinline__ unsigned xb_add(unsigned* p, unsigned v) { return __hip_atomic_fetch_add(p, v, __ATOMIC_RELAXED, __HIP_MEMORY_SCOPE_AGENT); }
__device__ __forceinline__ unsigned xb_xcc_id() { return (unsigned)__builtin_amdgcn_s_getreg((3 << 11) | 20) & 0xFu; }
#define XB_SPIN(cond, bar) do { unsigned _sp = 0; while (cond) { __builtin_amdgcn_s_sleep(1); \
    if ((++_sp & 255u) == 0u) { if (xb_ld(&(bar)[XB_TMO])) break; if (_sp > XB_SPIN_CAP) { atomicAdd(&(bar)[XB_TMO], 1u); break; } } } } while (0)

struct XcdBarrier {
    unsigned* bar; unsigned x;
    volatile LAS unsigned* st;
};

__device__ __forceinline__ XcdBarrier xcd_barrier_post(unsigned* bar, volatile LAS unsigned* st) {
    XcdBarrier b; b.bar = bar; b.x = xb_xcc_id(); b.st = st;
    if (threadIdx.x == 0) (void)xb_add(&bar[XB_XCNT(b.x)], 1u);
    return b;
}
__device__ __forceinline__ void xcd_barrier_complete(unsigned* bar, unsigned x, unsigned& nloc, unsigned& nx) {
    const unsigned G = gridDim.x * gridDim.y * gridDim.z;
    unsigned sum, cnt, mine, sp = 0u;
    for (;;) {
        sum = 0u; cnt = 0u; mine = 0u;
#pragma unroll
        for (unsigned j = 0; j < 16; ++j) { const unsigned c = xb_ld(&bar[XB_XCNT(j)]); sum += c; cnt += (c > 0u) ? 1u : 0u; mine = (j == x) ? c : mine; }
        if (sum == G) break;
        __builtin_amdgcn_s_sleep(1);
        if ((++sp & 255u) == 0u) { if (xb_ld(&bar[XB_TMO])) break; if (sp > XB_SPIN_CAP) { atomicAdd(&bar[XB_TMO], 1u); break; } }
    }
    nloc = mine > 0u ? mine : 1u; nx = cnt > 0u ? cnt : 1u;
}

__device__ __forceinline__ void xcd_barrier(const XcdBarrier& b) {
    asm volatile("s_waitcnt vmcnt(0)" ::: "memory");
    __syncthreads();
    if (threadIdx.x == 0) {
        unsigned* bar = b.bar;
        __builtin_amdgcn_s_waitcnt(0);
        unsigned nloc = b.st[0], nx = b.st[1];
        if (nloc == 0u) { xcd_barrier_complete(bar, b.x, nloc, nx); b.st[0] = nloc; b.st[1] = nx; }
        const unsigned old = xb_add(&bar[XB_XSUB(b.x)], 1u);
        const unsigned gen = old / nloc;
        if (old + 1u == (gen + 1u) * nloc) {
            __builtin_amdgcn_fence(__ATOMIC_RELEASE, "agent");
            asm volatile("s_waitcnt vmcnt(0)" ::: "memory");
            const unsigned og = xb_add(&bar[XB_TOP], 1u);
            const unsigned tg = og / nx;
            if (og + 1u == (tg + 1u) * nx) xb_add(&bar[XB_TOPGEN], 1u);
            else XB_SPIN(xb_ld(&bar[XB_TOPGEN]) == tg, bar);
            __builtin_amdgcn_fence(__ATOMIC_ACQUIRE, "agent");
            xb_add(&bar[XB_XGEN(b.x)], 1u);
            asm volatile("s_waitcnt vmcnt(0)" ::: "memory");
        } else {
            XB_SPIN(xb_ld(&bar[XB_XGEN(b.x)]) == gen, bar);
            __builtin_amdgcn_fence(__ATOMIC_ACQUIRE, "agent");
            asm volatile("s_waitcnt vmcnt(0)" ::: "memory");
        }
    }
    __syncthreads();
}

struct Args { const float* in[22]; float* out; unsigned char* ws; int ph_lo, ph_hi; };
enum { I_X = 0, I_MEM, I_F1N, I_F1G, I_F1U, I_F1D, I_MIXN, I_WIN, I_QN, I_KN, I_RELB, I_WOUT, I_MXN, I_MMN, I_WQM, I_WKVM, I_WOM, I_F2N, I_F2G, I_F2U, I_F2D, I_FIN };

__global__ void __launch_bounds__(NWAVES * 64, 2) mk_fwd(Args args) {
    extern __shared__ __attribute__((aligned(16))) unsigned char lds[];
    LAS unsigned char* ldsl = (LAS unsigned char*)lds;
    const int tid = threadIdx.x, lane = tid & 63, wave = __builtin_amdgcn_readfirstlane(tid >> 6);
    const int G = gridDim.x, bx = blockIdx.x;
    const int vcu = (G % 8 == 0) ? (bx % 8) * (G / 8) + bx / 8 : bx;
    const int gw = vcu * NWAVES + wave, NGW = G * NWAVES;
    unsigned char* ws = args.ws;
    float* out = args.out;
#define WGU1 ((bf16r*)(ws + WS_WGU1))
#define WD1 ((bf16r*)(ws + WS_WD1))
#define WGU2 ((bf16r*)(ws + WS_WGU2))
#define WD2 ((bf16r*)(ws + WS_WD2))
#define WIN ((bf16r*)(ws + WS_WIN))
#define WOUT ((bf16r*)(ws + WS_WOUT))
#define WQM ((bf16r*)(ws + WS_WQM))
#define WKVM ((bf16r*)(ws + WS_WKVM))
#define WOM ((bf16r*)(ws + WS_WOM))
#define HM ((bf16r*)(ws + WS_HM))
#define KVM ((bf16r*)(ws + WS_KVM))
#define LSE ((float*)(ws + WS_LSE))
#define H ((bf16r*)(ws + WS_H))
#define PROJ ((bf16r*)(ws + WS_PROJ))
#define ACT ((bf16r*)(ws + WS_ACT))
#define QM ((bf16r*)(ws + WS_QM))
#define OM ((bf16r*)(ws + WS_OM))
#define MIX ((bf16r*)out)
#define PCNT ((unsigned*)(ws + 32768))
#define SS ((float*)(ws + 65536))
#define XB2 ((bf16r*)(ws + WS_PROJ + 64 * MiB))
    const int lo = args.ph_lo, hi = args.ph_hi;
#ifndef PH_MASK
#define PH_MASK 0x1ffff
#endif
#define IN(k) (((PH_MASK >> (k)) & 1) && lo <= (k) && (k) < hi)
    volatile LAS unsigned* MISC = (volatile LAS unsigned*)(ldsl + RING_BYTES);
    if (tid < 16) MISC[tid] = 0u;
    __syncthreads();
    unsigned* barw = (unsigned*)ws;
    XcdBarrier xb; xb.bar = barw; xb.x = 0; xb.st = MISC;
#define SEAM(k) do { if (IN(k) && IN((k) + 1) && MK_N_LAUNCHES == 1) { if ((k) == 0) { cg::this_grid().sync(); xb = xcd_barrier_post(barw, MISC); } else { xcd_barrier(xb); } } } while (0)

    if (IN(0)) {
        if (bx == 0) { for (int t = tid; t < XCD_BAR_WORDS; t += NWAVES * 64) barw[t] = 0u; }
        LAS float* scr = (LAS float*)(ldsl + wave * 16384);
        constexpr int I_FG = (DM / 64) * (DFF / 32), I_FD = (DFF / 64) * (DM / 32), I_IN = (DM / 64) * (INW / 32), I_OUT = (DM / 64) * (DM / 32),
                      I_QM = (DM / 64) * (MEMW / 32), I_KVM = (DM / 64) * (2 * MEMW / 32), I_OM = (MEMW / 64) * (DM / 32);
        constexpr int NITEMS = 4 * I_FG + 2 * I_FD + I_IN + I_OUT + I_QM + I_KVM + I_OM;
        for (int it = gw; it < NITEMS; it += NGW) {
            int r = it;
            if (r < I_FG) { transpose_mat(args.in[I_F1G], DM, DFF, WGU1, 1, r, scr, lane); continue; } r -= I_FG;
            if (r < I_FG) { transpose_mat(args.in[I_F1U], DM, DFF, WGU1, 2, r, scr, lane); continue; } r -= I_FG;
            if (r < I_FD) { transpose_mat(args.in[I_F1D], DFF, DM, WD1, 0, r, scr, lane); continue; } r -= I_FD;
            if (r < I_IN) { transpose_mat(args.in[I_WIN], DM, INW, WIN, 0, r, scr, lane, args.in[I_MIXN]); continue; } r -= I_IN;
            if (r < I_OUT) { transpose_mat(args.in[I_WOUT], DM, DM, WOUT, 0, r, scr, lane); continue; } r -= I_OUT;
            if (r < I_QM) { transpose_mat(args.in[I_WQM], DM, MEMW, WQM, 0, r, scr, lane, args.in[I_MXN]); continue; } r -= I_QM;
            if (r < I_KVM) { transpose_mat(args.in[I_WKVM], DM, 2 * MEMW, WKVM, 0, r, scr, lane); continue; } r -= I_KVM;
            if (r < I_OM) { transpose_mat(args.in[I_WOM], MEMW, DM, WOM, 0, r, scr, lane); continue; } r -= I_OM;
            if (r < I_FG) { transpose_mat(args.in[I_F2G], DM, DFF, WGU2, 1, r, scr, lane, args.in[I_F2N]); continue; } r -= I_FG;
            if (r < I_FG) { transpose_mat(args.in[I_F2U], DM, DFF, WGU2, 2, r, scr, lane, args.in[I_F2N]); continue; } r -= I_FG;
            transpose_mat(args.in[I_F2D], DFF, DM, WD2, 0, r, scr, lane);
        }
        for (int i = gw * 64 + lane; i < 4 * MTOK; i += NGW * 64) SS[i] = 0.f;
        for (int i = gw * 64 + lane; i < 128 * 64; i += NGW * 64) PCNT[i] = 0u;
        for (int m = gw; m < MTOK; m += NGW) rms_row_bf16(args.in[I_X] + (size_t)m * DM, args.in[I_F1N], H + (size_t)m * DM, lane);
        for (int m = gw; m < BATCH * MEMT; m += NGW) rms_row_bf16(args.in[I_MEM] + (size_t)m * DM, args.in[I_MMN], HM + (size_t)m * DM, lane);
        __syncthreads();
    }
    SEAM(0);
    if (IN(1)) {
        { pg8::Gemm g{H, WGU1, MTOK, 2 * DFF, DM}; pg8::StaticOrder S; S.init(MTOK, 2 * DFF, G, bx);
          pg8::EpiSwiGLU<false> E{ACT, DFF, nullptr};
          pg8::gemm_phase<pg8::EpiSwiGLU<false>, pg8::StaticOrder, true, true>(ldsl, g, S, E); }
        { pg8::Gemm g{HM, WKVM, BATCH * MEMT, 2 * MEMW, DM}; pg8::StaticOrder S; S.init(BATCH * MEMT, 2 * MEMW, G, bx);
          pg8::EpiBf16<false> E{KVM, 2 * MEMW, nullptr};
          pg8::gemm_phase<pg8::EpiBf16<false>, pg8::StaticOrder, true, true>(ldsl, g, S, E); }
    }
    SEAM(1);
    if (IN(2)) {
        pg8::Gemm g{ACT, WD1, MTOK, DM, DFF}; pg8::StaticOrder S; S.init(MTOK, DM, G, bx, 4);
        pg8::EpiRes<false, false, true> E{args.in[I_X], nullptr, nullptr, H, SS, DM, 0.5f};
        pg8::gemm_phase<pg8::EpiRes<false, false, true>, pg8::StaticOrder, true, true>(ldsl, g, S, E);
    }
    SEAM(2);
    if (IN(4)) {
        pg8::Gemm g{H, WIN, MTOK, INW, DM}; pg8::StaticOrder S; S.init(MTOK, INW, G, bx);
        pg8::EpiBf16<true> E{PROJ, INW, SS};
        pg8::gemm_phase<pg8::EpiBf16<true>, pg8::StaticOrder, true, true>(ldsl, g, S, E);
    }
    SEAM(4);
    if (IN(5)) {
        const int hh = lane >> 5, a = (lane >> 4) & 1, i = (lane & 15) * 2;
        const float invf0 = exp2f(-(float)i * 0.41524101186092029f), invf1 = exp2f(-(float)(i + 1) * 0.41524101186092029f);
        const float* qn = args.in[I_QN] + a * 64 + i; const float* kn = args.in[I_KN] + a * 64 + i;
        const float gq1a = qn[0], gq1b = qn[1], gq2a = qn[32], gq2b = qn[33], gk1a = kn[0], gk1b = kn[1], gk2a = kn[32], gk2b = kn[33];
        for (int row = gw; row < MTOK; row += NGW) {
            const int s = row & (SEQ - 1);
            const float pos = (float)(a == 0 ? (s >> 6) : (s & 63));
            const float rev0 = pos * invf0 * 0.15915494309189535f, rev1 = pos * invf1 * 0.15915494309189535f;
            const float sn0 = __builtin_amdgcn_sinf(rev0), cs0 = __builtin_amdgcn_cosf(rev0), sn1 = __builtin_amdgcn_sinf(rev1), cs1 = __builtin_amdgcn_cosf(rev1);
            unsigned* prow = (unsigned*)(PROJ + (size_t)row * INW + a * 64 + i);
#pragma unroll
            for (int it = 4; it < 5; ++it) {
                unsigned* p = prow + (it * 2 + hh) * 64;
                const unsigned u1 = p[0], u2 = p[16];
                const float x1a = __builtin_bit_cast(float, u1 << 16), x1b = __builtin_bit_cast(float, u1 & 0xffff0000u);
                const float x2a = __builtin_bit_cast(float, u2 << 16), x2b = __builtin_bit_cast(float, u2 & 0xffff0000u);
                float ss = (x1a * x1a + x1b * x1b) + (x2a * x2a + x2b * x2b);
#pragma unroll
                for (int o = 1; o < 32; o <<= 1) ss += __shfl_xor(ss, o);
                const float rstd = 1.0f / sqrtf(ss * (1.f / 128.f) + EPS);
                const bool isq = it < 4;
                const float y1a = x1a * rstd * (isq ? gq1a : gk1a), y1b = x1b * rstd * (isq ? gq1b : gk1b);
                const float y2a = x2a * rstd * (isq ? gq2a : gk2a), y2b = x2b * rstd * (isq ? gq2b : gk2b);
                p[0] = pk2(y1a * cs0 - y2a * sn0, y1b * cs1 - y2b * sn1);
                p[16] = pk2(y2a * cs0 + y1a * sn0, y2b * cs1 + y1b * sn1);
            }
        }
    }
    SEAM(5);
    if (IN(6)) {
        const att::bf16* P = (const att::bf16*)PROJ;
        int u0, ustep, uend;
        if (G % 8 == 0) { const int per = G / 8, x = vcu / per, j = vcu % per; u0 = x * 128 + j; ustep = per; uend = x * 128 + 128; }
        else { u0 = bx; ustep = G; uend = 1024; }
        float* tab = (float*)((char*)lds + att::SHM_ATTN);
        const int bper = (3072 + G - 1) / G; int gh_prev = -1;
        const int bu0 = vcu * bper, bu1 = (bu0 + bper < 3072) ? bu0 + bper : 3072;
        const int nA = (uend > u0) ? (uend - u0 + ustep - 1) / ustep : 0;
        const int bchunk = (nA > 0) ? (bper + nA - 1) / nA : bper;
        const int nBc = (bu1 > bu0) ? (bu1 - bu0 + bchunk - 1) / bchunk : 0;
        const int nsteps = 2 * (nA > nBc ? nA : nBc), par = (G % 8 == 0) ? ((vcu / (G / 8)) & 1) : (vcu & 1);
        for (int step = 0; step < nsteps; ++step) {
            const int k = step >> 1;
            if (((step + par) & 1) == 0) {
                const int u = u0 + k * ustep;
                if (k < nA && u < uend) {
                    const int combo = u >> 8, b = combo >> 1, kvh = combo & 1, hq = kvh * 4 + ((u >> 6) & 3), qb = u & 63;
                    const size_t rowq = (size_t)b * SEQ + (size_t)qb * 256;
                    att::attn_unit<0, true>(P + rowq * INW + O_QA + hq * 128, INW, P + (size_t)b * SEQ * INW + O_KA + kvh * 128, P + (size_t)b * SEQ * INW + O_VA + kvh * 128, INW,
                                      (att::bf16*)MIX + rowq * DM + hq * 128, DM, SEQ / 64, (char*)lds, 0, 0, nullptr, nullptr, 0, args.in[I_QN], qb * 256);
                    gh_prev = -1;
                }
            } else {
                for (int u = bu0 + k * bchunk; u < bu1 && u < bu0 + (k + 1) * bchunk; ++u) {
                    const int g = u >> 10, b = (u >> 9) & 1, h = (u >> 6) & 7, idx = u & 63;
                    const int r = (g == 0) ? 1 : (g == 1 ? 4 : 16), npos = SEQ / r, nblk = npos / 256, c = idx / nblk, qb = idx % nblk, a0 = qb * 256;
                    if ((g * 8 + h) != gh_prev) { gh_prev = g * 8 + h;
                    for (int t = tid; t < att::TAB_N; t += NWAVES * 64) { const int d = t - att::TAB_PAD;
                        tab[t] = (d >= -64 && d <= 64) ? args.in[I_RELB][t5_bucket(r * d) * 24 + g * 8 + h] * (1.0f / att::SCALE) : -INFINITY; } }
                    const size_t row0 = (size_t)b * SEQ + c;
                    const long ld = (long)r * INW;
                    att::bf16* Pq = (att::bf16*)PROJ + row0 * INW + O_QB + g * 1024 + h * 128;
                    const att::bf16* Pk = P + row0 * INW + O_KB + g * 1024 + h * 128;
                    const att::bf16* Pv = P + row0 * INW + O_VB + g * 1024 + h * 128;
                    float* lse = LSE + ((size_t)g * MTOK + row0 + (size_t)a0 * r) * 8 + h;
                    att::attn_unit<1>(Pq + (long)a0 * ld, ld, Pk, Pv, ld, Pq + (long)a0 * ld, ld, 6, (char*)lds, a0 - 64, npos, tab, lse, (long)r * 8);
                }
            }
        }
    }
    SEAM(6);
    if (IN(7)) {
        for (int m = gw; m < MTOK; m += NGW) {
#pragma unroll
            for (int j = 0; j < 2; ++j) {
                const int e = j * 512 + lane * 8, h = e >> 7;
                const float l0 = LSE[((size_t)0 * MTOK + m) * 8 + h], l1 = LSE[((size_t)1 * MTOK + m) * 8 + h], l2 = LSE[((size_t)2 * MTOK + m) * 8 + h];
                const float mx = fmaxf(l0, fmaxf(l1, l2)); float w0 = __expf(l0 - mx), w1 = __expf(l1 - mx), w2 = __expf(l2 - mx);
                const float inv = 1.0f / (w0 + w1 + w2); w0 *= inv; w1 *= inv; w2 *= inv;
                const bf16r* p = PROJ + (size_t)m * INW + O_QB + e;
                const v4u a0 = *(const v4u*)p, a1 = *(const v4u*)(p + 1024), a2 = *(const v4u*)(p + 2048);
                v4u o;
#pragma unroll
                for (int q = 0; q < 4; ++q) {
                    const float x0 = __builtin_bit_cast(float, a0[q] << 16), y0 = __builtin_bit_cast(float, a0[q] & 0xffff0000u);
                    const float x1 = __builtin_bit_cast(float, a1[q] << 16), y1 = __builtin_bit_cast(float, a1[q] & 0xffff0000u);
                    const float x2 = __builtin_bit_cast(float, a2[q] << 16), y2 = __builtin_bit_cast(float, a2[q] & 0xffff0000u);
                    o[q] = pk2(w0 * x0 + w1 * x1 + w2 * x2, w0 * y0 + w1 * y1 + w2 * y2);
                }
                *(v4u*)(MIX + (size_t)m * DM + 1024 + e) = o;
            }
        }
    }
    SEAM(7);
    if (IN(8)) {
        pg8::Gemm g{MIX, WOUT, MTOK, DM, DM}; pg8::StaticOrder S; S.init(MTOK, DM, G, bx, 4);
        pg8::EpiRes<true, false, true> E{nullptr, H, nullptr, XB2, SS + MTOK, DM, 1.0f};
        pg8::gemm_phase<pg8::EpiRes<true, false, true>, pg8::StaticOrder, true, true>(ldsl, g, S, E);
    }
    SEAM(8);
    if (IN(10)) {
        pg8::Gemm g{XB2, WQM, MTOK, MEMW, DM}; pg8::StaticOrder S; S.init(MTOK, MEMW, G, bx);
        pg8::EpiBf16<true> E{QM, MEMW, SS + MTOK};
        pg8::gemm_phase<pg8::EpiBf16<true>, pg8::StaticOrder, true, true>(ldsl, g, S, E);
    }
    SEAM(10);
    if (IN(11)) {
        for (int u = vcu; u < 512; u += G) {
            const int qb = u >> 2, h = u & 3; const size_t rowq = (size_t)qb * 256; const int b = (int)(rowq / SEQ);
            const att::bf16* kv = (const att::bf16*)KVM + (size_t)b * MEMT * (2 * MEMW);
            att::attn_unit<0>((const att::bf16*)QM + rowq * MEMW + h * 128, MEMW, kv + h * 128, kv + MEMW + h * 128, 2 * MEMW,
                              (att::bf16*)OM + rowq * MEMW + h * 128, MEMW, MEMT / 64, (char*)lds, 0, 0, nullptr, nullptr, 0);
        }
    }
    SEAM(11);
    if (IN(12)) {
        pg8::Gemm g{OM, WOM, MTOK, DM, MEMW}; pg8::StaticOrder S; S.init(MTOK, DM, G, bx, 4);
        pg8::EpiRes<true, false, true> E{nullptr, XB2, nullptr, H, SS + 2 * MTOK, DM, 1.0f};
        pg8::gemm_phase<pg8::EpiRes<true, false, true>, pg8::StaticOrder, true, true>(ldsl, g, S, E);
    }
    SEAM(12);
    if (IN(14)) {
        pg8::Gemm g{H, WGU2, MTOK, 2 * DFF, DM}; pg8::StaticOrder S; S.init(MTOK, 2 * DFF, G, bx);
        pg8::EpiSwiGLU<true> E{ACT, DFF, SS + 2 * MTOK};
        pg8::gemm_phase<pg8::EpiSwiGLU<true>, pg8::StaticOrder, true, true>(ldsl, g, S, E);
    }
    SEAM(14);
    if (IN(15)) {
        pg8::Gemm g{ACT, WD2, MTOK, DM, DFF}; pg8::StaticOrder S; S.init(MTOK, DM, G, bx, 4);
        pg8::EpiFinal E{H, out, SS + 3 * MTOK, PCNT, args.in[I_FIN], DM, 0.5f, (unsigned)(DM / 256)};
        pg8::gemm_phase<pg8::EpiFinal, pg8::StaticOrder, true, true>(ldsl, g, S, E);
    }
#undef IN
#undef SEAM
}

extern "C" void kernel_launch(void* const* d_in, const int* in_sizes, int n_in, void* d_out, int out_size, void* d_ws, size_t ws_size, hipStream_t stream) {
    static int grid = 0;
    if (grid == 0) {
        if (n_in != 22 || in_sizes[0] != MTOK * DM || out_size != MTOK * DM || ws_size < WS_END) {
            fprintf(stderr, "kernel_launch: unexpected shapes: n_in %d in0 %d out %d ws %zu (need >= %zu)\n", n_in, n_in > 0 ? in_sizes[0] : -1, out_size, ws_size, (size_t)WS_END); grid = -1; return; }
        int dev = 0, cus = 0, per_cu = 0;
        if (hipGetDevice(&dev) != hipSuccess || hipDeviceGetAttribute(&cus, hipDeviceAttributeMultiprocessorCount, dev) != hipSuccess) { fprintf(stderr, "kernel_launch: device query failed\n"); grid = -1; return; }
        if (hipFuncSetAttribute((const void*)mk_fwd, hipFuncAttributeMaxDynamicSharedMemorySize, LDS_BYTES) != hipSuccess) { fprintf(stderr, "kernel_launch: hipFuncSetAttribute failed\n"); grid = -1; return; }
        if (hipOccupancyMaxActiveBlocksPerMultiprocessor(&per_cu, (const void*)mk_fwd, NWAVES * 64, LDS_BYTES) != hipSuccess || per_cu < 1) { fprintf(stderr, "kernel_launch: occupancy query gave %d\n", per_cu); per_cu = 1; }
        (void)hipGetLastError();
        grid = cus * 1;
        fprintf(stderr, "kernel_launch: grid %d (cus %d, per_cu %d)\n", grid, cus, per_cu);
    }
    if (grid < 0) return;
    Args a{};
    for (int i = 0; i < 22; ++i) a.in[i] = (const float*)d_in[i];
    a.out = (float*)d_out; a.ws = (unsigned char*)d_ws;
    if (MK_N_LAUNCHES == 1) {
        a.ph_lo = 0; a.ph_hi = NPH;
        void* kargs[] = {&a};
        hipError_t e = hipLaunchCooperativeKernel((const void*)mk_fwd, dim3(grid), dim3(NWAVES * 64), kargs, LDS_BYTES, stream);
        if (e != hipSuccess) fprintf(stderr, "kernel_launch: cooperative launch failed: %s (grid %d)\n", hipGetErrorString(e), grid);
    } else {
        for (int p = 0; p < NPH; ++p) {
            a.ph_lo = p; a.ph_hi = p + 1;
            hipLaunchKernelGGL(mk_fwd, dim3(grid), dim3(NWAVES * 64), LDS_BYTES, stream, a);
        }
        hipError_t e = hipPeekAtLastError();
        if (e != hipSuccess) fprintf(stderr, "kernel_launch: launch failed: %s\n", hipGetErrorName(e));
    }
}
```
